# Optimizing an MI355X kernel written in HIP

```python
import math
import jax, jax.numpy as jnp
from jax import lax
import numpy as np

D_MODEL = 1024
BATCH = 16
SEQ = 2048
DEPTH = 1
DEC_BATCH = 16
DEC_SEQ = 32
PAST_LEN = 2048

CHUNK = 64
N_RET_HEADS = 4
RET_QK_DIM = D_MODEL // N_RET_HEADS
RET_V_DIM = 2 * RET_QK_DIM
RET_QK_WIDTH = N_RET_HEADS * RET_QK_DIM
RET_V_WIDTH = N_RET_HEADS * RET_V_DIM
CONV_WIDTH = D_MODEL
CONV_GROUPS = 8
CONV_K = 3
FFN_CONV_K = 3
D_FF = 2816
ROPE_BASE = 10000.0
LN_EPS = 1e-5
ALPHA = (2.0 * DEPTH) ** 0.25
BETA = (8.0 * DEPTH) ** -0.25
SPLIT_SIZES = (RET_QK_WIDTH, RET_QK_WIDTH, RET_V_WIDTH, RET_V_WIDTH,
               CONV_WIDTH, CONV_WIDTH, CONV_WIDTH, D_MODEL, D_MODEL)
SPLIT_POINTS = tuple(int(s) for s in np.cumsum(SPLIT_SIZES)[:-1])
N_IN = int(sum(SPLIT_SIZES))

kernel_name = "hybrid_retention_shortconv_streaming_step"


def _layer_norm(x, g, b):
    xf = x.astype(jnp.float32)
    mu = jnp.mean(xf, axis=-1, keepdims=True)
    var = jnp.mean(jnp.square(xf - mu), axis=-1, keepdims=True)
    return ((xf - mu) * lax.rsqrt(var + LN_EPS)).astype(x.dtype) * g + b


def _head_norm(o):
    mu = jnp.mean(o, axis=-1, keepdims=True)
    var = jnp.mean(jnp.square(o - mu), axis=-1, keepdims=True)
    return (o - mu) * lax.rsqrt(var + LN_EPS)


def _rotary(x, pos):
    half = x.shape[-1] // 2
    inv_freq = ROPE_BASE ** (-jnp.arange(half, dtype=jnp.float32) / half)
    ang = pos.astype(jnp.float32)[:, None] * inv_freq[None, :]
    cos = jnp.cos(ang)[None, :, None, :]
    sin = jnp.sin(ang)[None, :, None, :]
    x1, x2 = x[..., 0::2], x[..., 1::2]
    return jnp.stack([x1 * cos - x2 * sin, x1 * sin + x2 * cos], axis=-1).reshape(x.shape)


def _ret_log_decay():
    return jnp.log1p(-jnp.exp2(-5.0 - jnp.arange(N_RET_HEADS, dtype=jnp.float32)))


def _retention_block(q, k, v, state, log_g):
    L = q.shape[1]
    idx = jnp.arange(L, dtype=jnp.float32)
    diff = idx[:, None] - idx[None, :]
    decay = jnp.where(diff >= 0.0, jnp.exp(log_g[:, None, None] * jnp.maximum(diff, 0.0)), 0.0)
    scores = jnp.einsum("bqhd,bkhd->bhqk", q, k) * decay[None]
    inner = jnp.einsum("bhqk,bkhe->bqhe", scores, v)
    q_dec = jnp.exp(log_g[None, :] * (idx[:, None] + 1.0))
    cross = jnp.einsum("bqhd,bhde->bqhe", q, state) * q_dec[None, :, :, None]
    k_dec = jnp.exp(log_g[None, :] * (L - 1.0 - idx[:, None]))
    new_state = (jnp.exp(log_g * L)[None, :, None, None] * state
                 + jnp.einsum("bkhd,bkhe->bhde", k * k_dec[None, :, :, None], v))
    return inner + cross, new_state


def _retention_prompt(q, k, v, log_g):
    B, L, H, dk = q.shape
    dv = v.shape[-1]
    nc = L // CHUNK

    def to_chunks(t):
        return jnp.swapaxes(t.reshape(B, nc, CHUNK, H, t.shape[-1]), 0, 1)

    def step(S, qkv):
        qc, kc, vc = qkv
        o, S = _retention_block(qc, kc, vc, S, log_g)
        return S, o

    s0 = jnp.zeros((B, H, dk, dv), jnp.float32)
    s_fin, o = lax.scan(step, s0, (to_chunks(q), to_chunks(k), to_chunks(v)))
    o = jnp.swapaxes(o, 0, 1).reshape(B, L, H, dv)
    return o, s_fin


def _causal_dwconv(u, hist, w, b):
    K = w.shape[0]
    L = u.shape[1]
    full = jnp.concatenate([hist.astype(u.dtype), u], axis=1)
    y = b + sum(full[:, j:j + L] * w[j] for j in range(K))
    return y, full[:, -(K - 1):]


def _token_mixer(h, pos, s_ret, conv_hist, w_in, w_o_ret, conv_w, conv_b, w_o_conv, w_out, b_out):
    B, L, _ = h.shape
    proj = h @ w_in
    q, k, v, g, b_gate, c_gate, x_in, gate_ret, gate_conv = jnp.split(proj, SPLIT_POINTS, axis=-1)
    qf = _rotary(q.reshape(B, L, N_RET_HEADS, RET_QK_DIM).astype(jnp.float32), pos)
    kf = _rotary(k.reshape(B, L, N_RET_HEADS, RET_QK_DIM).astype(jnp.float32), pos) * (RET_QK_DIM ** -0.5)
    vf = v.reshape(B, L, N_RET_HEADS, RET_V_DIM).astype(jnp.float32)
    log_g = _ret_log_decay()
    if s_ret is None:
        o, s_new = _retention_prompt(qf, kf, vf, log_g)
    else:
        o, s_new = _retention_block(qf, kf, vf, s_ret.astype(jnp.float32), log_g)
    o = _head_norm(o).reshape(B, L, RET_V_WIDTH).astype(h.dtype)
    y_ret = (jax.nn.silu(g) * o) @ w_o_ret
    u = c_gate * x_in
    if conv_hist is None:
        conv_hist = jnp.zeros((B, CONV_K - 1, CONV_WIDTH), u.dtype)
    conv_out, hist_new = _causal_dwconv(u, conv_hist, conv_w, conv_b)
    y_conv = (b_gate * conv_out) @ w_o_conv
    merged = jax.nn.sigmoid(gate_ret) * y_ret + jax.nn.sigmoid(gate_conv) * y_conv
    return merged @ w_out + b_out, s_new, hist_new


def _conv_ffn(h, hist, w_up, conv_w, conv_b, w_down, b_down):
    a, gb = jnp.split(h @ w_up, 2, axis=-1)
    if hist is None:
        hist = jnp.zeros((h.shape[0], FFN_CONV_K - 1, D_FF), a.dtype)
    a_conv, hist_new = _causal_dwconv(a, hist, conv_w, conv_b)
    return (jax.nn.gelu(a_conv, approximate=False) * gb) @ w_down + b_down, hist_new


def _trunk(x, c, pos, ret_state, conv_state, ffn_state, p):
    (ln_in_g, ln_in_b, w_mod, b_mod, w_in, w_o_ret, conv_w, conv_b, w_o_conv,
     w_out, b_out, ln1_g, ln1_b, w_up, ffn_conv_w, ffn_conv_b, w_down, b_down,
     ln2_g, ln2_b) = p
    x = _layer_norm(x, ln_in_g, ln_in_b)
    rets, convs, ffns = [], [], []
    for l in range(DEPTH):
        mod = (c @ w_mod[l] + b_mod[l])[:, None, :]
        sh_t, sc_t, g_t, sh_c, sc_c, g_c = jnp.split(mod, 6, axis=-1)
        h = x * (1.0 + sc_t) + sh_t
        mix, s_new, ch_new = _token_mixer(
            h, pos,
            None if ret_state is None else ret_state[l],
            None if conv_state is None else conv_state[l],
            w_in[l], w_o_ret[l], conv_w[l], conv_b[l], w_o_conv[l], w_out[l], b_out[l])
        x = _layer_norm(ALPHA * x + g_t * mix, ln1_g[l], ln1_b[l])
        h2 = x * (1.0 + sc_c) + sh_c
        ffn, fh_new = _conv_ffn(h2, None if ffn_state is None else ffn_state[l],
                                w_up[l], ffn_conv_w[l], ffn_conv_b[l], w_down[l], b_down[l])
        x = _layer_norm(ALPHA * x + g_c * ffn, ln2_g[l], ln2_b[l])
        rets.append(s_new)
        convs.append(ch_new)
        ffns.append(fh_new)
    return x, jnp.stack(rets), jnp.stack(convs), jnp.stack(ffns)


def setup_inputs(seed: int = 0) -> dict:
    key = jax.random.key(seed)
    ks = jax.random.split(key, 32)

    def nrm(k, shape, s):
        return jax.random.normal(k, shape, jnp.float32) * s

    D = D_MODEL
    col_scale = jnp.concatenate([
        jnp.ones((2 * RET_QK_WIDTH,), jnp.float32),
        jnp.full((RET_V_WIDTH,), BETA, jnp.float32),
        jnp.ones((N_IN - 2 * RET_QK_WIDTH - RET_V_WIDTH,), jnp.float32)])
    return {
        "x_prompt": nrm(ks[0], (BATCH, SEQ, D), 1.0),
        "x_sample": nrm(ks[1], (DEC_BATCH, DEC_SEQ, D), 1.0),
        "c_prompt": nrm(ks[2], (BATCH, D), 1.0),
        "c_sample": nrm(ks[3], (DEC_BATCH, D), 1.0),
        "state_retention": nrm(ks[4], (DEPTH, DEC_BATCH, N_RET_HEADS, RET_QK_DIM, RET_V_DIM), 0.1),
        "state_shortconv": nrm(ks[5], (DEPTH, DEC_BATCH, CONV_K - 1, CONV_WIDTH), 1.0),
        "state_ffn_conv": nrm(ks[6], (DEPTH, DEC_BATCH, FFN_CONV_K - 1, D_FF), 1.0),
        "ln_in_g": 1.0 + nrm(ks[7], (D,), 0.01),
        "ln_in_b": nrm(ks[8], (D,), 0.01),
        "w_mod": nrm(ks[9], (DEPTH, D, 6 * D), 0.5 * D ** -0.5),
        "b_mod": nrm(ks[10], (DEPTH, 6 * D), 0.01),
        "w_in": nrm(ks[11], (DEPTH, D, N_IN), D ** -0.5) * col_scale,
        "w_o_ret": nrm(ks[12], (DEPTH, RET_V_WIDTH, D), BETA * RET_V_WIDTH ** -0.5),
        "conv_w": nrm(ks[13], (DEPTH, CONV_K, CONV_WIDTH), CONV_K ** -0.5),
        "conv_b": nrm(ks[14], (DEPTH, CONV_WIDTH), 0.01),
        "w_o_conv": nrm(ks[15], (DEPTH, CONV_WIDTH, D), BETA * CONV_WIDTH ** -0.5),
        "w_out": nrm(ks[16], (DEPTH, D, D), BETA * D ** -0.5),
        "b_out": nrm(ks[17], (DEPTH, D), 0.01),
        "ln1_g": 1.0 + nrm(ks[18], (DEPTH, D), 0.01),
        "ln1_b": nrm(ks[19], (DEPTH, D), 0.01),
        "w_up": nrm(ks[20], (DEPTH, D, 2 * D_FF), D ** -0.5),
        "ffn_conv_w": nrm(ks[21], (DEPTH, FFN_CONV_K, D_FF), FFN_CONV_K ** -0.5),
        "ffn_conv_b": nrm(ks[22], (DEPTH, D_FF), 0.01),
        "w_down": nrm(ks[23], (DEPTH, D_FF, D), BETA * D_FF ** -0.5),
        "b_down": nrm(ks[24], (DEPTH, D), 0.01),
        "ln2_g": 1.0 + nrm(ks[25], (DEPTH, D), 0.01),
        "ln2_b": nrm(ks[26], (DEPTH, D), 0.01),
    }


def reference(x_prompt, x_sample, c_prompt, c_sample, state_retention, state_shortconv, state_ffn_conv,
              ln_in_g, ln_in_b, w_mod, b_mod, w_in, w_o_ret, conv_w, conv_b, w_o_conv, w_out, b_out,
              ln1_g, ln1_b, w_up, ffn_conv_w, ffn_conv_b, w_down, b_down, ln2_g, ln2_b):
    p = (ln_in_g, ln_in_b, w_mod, b_mod, w_in, w_o_ret, conv_w, conv_b, w_o_conv,
         w_out, b_out, ln1_g, ln1_b, w_up, ffn_conv_w, ffn_conv_b, w_down, b_down,
         ln2_g, ln2_b)
    pos_prompt = jnp.arange(x_prompt.shape[1], dtype=jnp.int32)
    pos_sample = PAST_LEN + jnp.arange(x_sample.shape[1], dtype=jnp.int32)
    y_prompt, ret_p, conv_p, ffn_p = _trunk(x_prompt, c_prompt, pos_prompt, None, None, None, p)
    y_sample, ret_s, conv_s, ffn_s = _trunk(x_sample, c_sample, pos_sample,
                                            state_retention, state_shortconv, state_ffn_conv, p)
    return (y_prompt, y_sample, ret_p, conv_p, ffn_p, ret_s, conv_s, ffn_s)
```

```cpp
#include <hip/hip_runtime.h>
#include <hip/hip_cooperative_groups.h>
#include <cstdio>
#include <cstdint>
namespace cg = cooperative_groups;

#define LAS __attribute__((address_space(3)))
typedef unsigned short bf16_t;
typedef short bf16x8 __attribute__((ext_vector_type(8)));
typedef float f32x4 __attribute__((ext_vector_type(4)));
typedef float f32x2 __attribute__((ext_vector_type(2)));
typedef unsigned u32x4 __attribute__((ext_vector_type(4)));
typedef unsigned u32x2 __attribute__((ext_vector_type(2)));

constexpr int T_ALL = 33280, T_PROMPT = 32768, DM = 1024, DFF = 2816;
constexpr float LN_EPS = 1e-5f;
constexpr float ALPHA = 1.189207115002721f;
constexpr size_t S1 = (size_t)T_ALL * 1024 * 2;
constexpr size_t OFF_WIN = 0, OFF_WCAT = 23068672, OFF_WOUT = 29360128, OFF_WUP = 31457280, OFF_WDOWN = 42991616;
constexpr size_t OFF_MODP = 62914560  , OFF_MOD = 55050240, OFF_ROT = 55836672, OFF_LNST = 57966592, OFF_RST = 58232832;
constexpr size_t OFF_ACT = 62914560;
constexpr size_t OFF_ACAT = OFF_ACT, OFF_Q = OFF_ACT + 3 * S1, OFF_K = OFF_ACT + 4 * S1, OFF_G = OFF_ACT + 3 * S1, OFF_R = OFF_ACT + 3 * S1, OFF_SC = OFF_ACT + 4 * S1;
constexpr size_t OFF_U = OFF_ACT + 5 * S1, OFF_MERGED = OFF_ACT + 5 * S1, OFF_MS32 = OFF_ACT + 6 * S1, OFF_RS_S = OFF_MS32 + (size_t)12 * 512 * 1024 * 4;
constexpr size_t OFF_X1 = OFF_ACT, OFF_AU = OFF_ACT + S1, OFF_GBF = OFF_AU + (size_t)T_ALL * DFF * 2;
constexpr size_t WS_NEED = OFF_GBF + (size_t)T_ALL * DFF * 2;
constexpr size_t OUT_YS = 33554432, OUT_RETP = 34078720, OUT_CONVP = 42467328, OUT_FFNP = 42500096, OUT_RETS = 42590208, OUT_CONVS = 50978816, OUT_FFNS = 51011584;
constexpr int LDS_BAR_OFF = 136192, LDS_BYTES = 136192 + 16;
constexpr size_t OFF_BAR = 62492672;

struct Params {
    const float *x_prompt, *x_sample, *c_prompt, *c_sample, *state_ret, *state_conv, *state_ffn;
    const float *ln_in_g, *ln_in_b, *w_mod, *b_mod, *w_in, *w_o_ret, *conv_w, *conv_b, *w_o_conv, *w_out, *b_out;
    const float *ln1_g, *ln1_b, *w_up, *ffn_conv_w, *ffn_conv_b, *w_down, *b_down, *ln2_g, *ln2_b;
    float* out; unsigned char* ws; int ph_lo, ph_hi, rep_mask, pad;
};

__device__ __forceinline__ unsigned cvt_pk_bf16(float lo, float hi) { unsigned r; asm volatile("v_cvt_pk_bf16_f32 %0, %1, %2" : "=v"(r) : "v"(lo), "v"(hi)); return r; }
__device__ __forceinline__ float bf_lo(unsigned w) { return __uint_as_float(w << 16); }
__device__ __forceinline__ float bf_hi(unsigned w) { return __uint_as_float(w & 0xffff0000u); }
__device__ __forceinline__ float wave_sum(float v) {
#pragma unroll
    for (int o = 1; o < 64; o <<= 1) v += __shfl_xor(v, o);
    return v;
}
__device__ __forceinline__ int row_seq(int row) { return row < T_PROMPT ? (row >> 11) : 16 + ((row - T_PROMPT) >> 5); }
__device__ __forceinline__ int row_pos(int row) { return row < T_PROMPT ? (row & 2047) : 2048 + ((row - T_PROMPT) & 31); }
__device__ __forceinline__ float sigmoidf_(float x) { return 1.0f / (1.0f + __expf(-x)); }
__device__ __forceinline__ float gelu_f(float v) {
    const float av = fabsf(v), t = __builtin_amdgcn_rcpf(av * 0.2316418882f + 1.0f);
    float q = t * 0.5307027145f + (-0.7265760135f); q = q * t + 0.7107068705f; q = q * t + (-0.142248368f); q = q * t + 0.127414796f; q = q * t;
    const float e = __builtin_amdgcn_exp2f((v * v) * (-0.72134752044f));
    const float m = v * (q * e);
    return v < 0.f ? m : v - m;
}

namespace pg8 {
constexpr int BM = 256, BK = 64, HALF = 128, HTB = HALF * BK * 2, STAGE_BYTES = 8 * HTB, NXCD = 8, WGM = 4;
__host__ __device__ __forceinline__ int lds_byte(int r, int c) { const int st = (r >> 4) * 2 + (c >> 5), rr = r & 15, cc = c & 31, ob = rr * 64 + cc * 2; return st * 1024 + (ob ^ (((ob >> 9) & 1) << 5)); }
__host__ __device__ __forceinline__ void stage_rc(int b, int& R, int& C) { const int st = b / 1024, sb = b % 1024, swz = sb ^ (((sb >> 9) & 1) << 5); R = (st >> 1) * 16 + swz / 64; C = (st & 1) * 32 + (swz % 64) / 2; }
__host__ __device__ __forceinline__ int perm32(int rho) { const int n = rho >> 4, i = rho & 15; return 8 * (i >> 2) + 4 * n + (i & 3); }
struct Unit { int pm, pn, kt0, nkt; };
struct Gemm { const bf16_t* A; const bf16_t* Bt; int M, N, K, lda; };
struct StaticOrder {
    int nM, nN, nwg, G, c, total, ntf, nMs, npk, pkt, ex_pm0, ex_pn0, ex_nN;
    __device__ void init(int M, int N, int G_, int c_, int K) { nM = M / BM; nN = N / BM; nwg = nM * nN; G = G_; c = c_; total = nwg; ntf = K / BK; nMs = 0; npk = 1; pkt = ntf; ex_pm0 = 0; ex_pn0 = 0; ex_nN = 1; }
    __device__ void split_tail(int tail_tiles, int piece_kt) { nM -= tail_tiles; nMs = tail_tiles; nwg = nM * nN; pkt = piece_kt; npk = ntf / piece_kt; ex_pm0 = nM; ex_pn0 = 0; ex_nN = nN; total = nwg + nMs * nN * npk; }
    __device__ void add_extra(int pm0, int ntiles, int pn0, int nNe) { nMs = ntiles; ex_pm0 = pm0; ex_pn0 = pn0; ex_nN = nNe; npk = 1; pkt = ntf; total = nwg + ntiles * nNe; }
    __device__ bool next(int i, Unit& u) const {
        const long L = (long)i * G + c; if (L >= total) return false;
        if (nMs > 0 && L >= nwg) { const int sp = (int)L - nwg, un = sp / npk, kp = sp - un * npk; u.pm = ex_pm0 + un / ex_nN; u.pn = ex_pn0 + un % ex_nN; u.kt0 = kp * pkt; u.nkt = pkt; return true; }
        int wgid = (int)(L >= nwg ? L - nwg : L); { const int q = nwg / NXCD, r = nwg % NXCD, xcd = wgid % NXCD, off = wgid / NXCD; wgid = (xcd < r ? xcd * (q + 1) : r * (q + 1) + (xcd - r) * q) + off; }
        const int nig = WGM * nN, gid = wgid / nig, fm = gid * WGM, gsz = (nM - fm) < WGM ? (nM - fm) : WGM;
        u.pm = fm + ((wgid % nig) % gsz); u.pn = (wgid % nig) / gsz; u.kt0 = 0; u.nkt = ntf; return true;
    }
};
template <class Epi>
__device__ __forceinline__ void gemm_phase(LAS unsigned char* lds, const Gemm g, const StaticOrder& S, const Epi& E) {
    const int tid = threadIdx.x, wid = __builtin_amdgcn_readfirstlane(tid >> 6), lane = tid & 63, wr = wid >> 2, wc = wid & 3, fr = lane & 15, fq = lane >> 4;
    const int K = g.K, ntf = K / BK;
    unsigned voffA[2], voffB[2];
#pragma unroll
    for (int i = 0; i < 2; ++i) { int R, C; stage_rc(tid * 16 + i * 8192, R, C); const int Rb = Epi::PERM ? ((R & ~31) + perm32(R & 31)) : R;
        voffA[i] = (unsigned)(R * g.lda + C) * 2u; voffB[i] = (unsigned)(Rb * K + C) * 2u; }
    const size_t kstep = (size_t)(BK * 2);
    const size_t hstepA = (size_t)HALF * g.lda * 2, hstepB = (size_t)HALF * K * 2;
    const size_t tstepA = 2 * hstepA, tstepB = 2 * hstepB;
    const unsigned ldsw = (unsigned)wid * 1024u;
    const int aoff = lds_byte(wr * 64 + fr, fq * 8), boff = lds_byte(wc * 32 + fr, fq * 8);
#define PG8_SA(b, h) (((b) * 2 + (h)) * HTB)
#define PG8_SB(b, h) ((4 + (b) * 2 + (h)) * HTB)
#define PG8_STAGE(bufoff, gbase, voff) do { _Pragma("unroll") for (int _i = 0; _i < 2; ++_i) \
        __builtin_amdgcn_global_load_lds((const unsigned*)((const char*)(gbase) + (voff)[_i]), (LAS unsigned*)(lds + (bufoff) + ldsw + _i * 8192), 16, 0, 0); } while (0)
#define PG8_LDA(dst, b, h) do { _Pragma("unroll") for (int m = 0; m < 4; ++m) _Pragma("unroll") for (int k = 0; k < 2; ++k) dst[m][k] = *(const LAS bf16x8*)(lds + PG8_SA(b, h) + aoff + m * 2048 + k * 1024); } while (0)
#define PG8_LDB(dst, b, h) do { _Pragma("unroll") for (int n = 0; n < 2; ++n) _Pragma("unroll") for (int k = 0; k < 2; ++k) dst[n][k] = *(const LAS bf16x8*)(lds + PG8_SB(b, h) + boff + n * 2048 + k * 1024); } while (0)
#define PG8_MMA(ai, bj, At, Bt) do { __builtin_amdgcn_s_setprio(1); _Pragma("unroll") for (int m = 0; m < 4; ++m) _Pragma("unroll") for (int n = 0; n < 2; ++n) _Pragma("unroll") for (int k = 0; k < 2; ++k) \
        acc[ai][bj][m][n] = __builtin_amdgcn_mfma_f32_16x16x32_bf16(Bt[n][k], At[m][k], acc[ai][bj][m][n], 0, 0, 0); __builtin_amdgcn_s_setprio(0); } while (0)
#define PG8_WAIT_V(n) asm volatile("s_waitcnt vmcnt(" #n ")" ::: "memory")
#define PG8_WAIT_L(n) asm volatile("s_waitcnt lgkmcnt(" #n ")" ::: "memory")
#define PG8_BAR __builtin_amdgcn_s_barrier()
#define PG8_SCHED __builtin_amdgcn_sched_barrier(0)
    Unit cur, nxt; int ui = 0;
    if (!S.next(0, cur)) return;
    f32x4 acc[2][2][4][2];
#pragma unroll
    for (int a = 0; a < 2; ++a)
#pragma unroll
        for (int b = 0; b < 2; ++b)
#pragma unroll
            for (int m = 0; m < 4; ++m)
#pragma unroll
                for (int n = 0; n < 2; ++n) acc[a][b][m][n] = (f32x4){0.f, 0.f, 0.f, 0.f};
    bf16x8 At[4][2], B0[2][2], B1[2][2];
    const char* cA = (const char*)g.A + (size_t)cur.pm * tstepA + (size_t)cur.kt0 * kstep; const char* cB = (const char*)g.Bt + (size_t)cur.pn * tstepB + (size_t)cur.kt0 * kstep;
    PG8_STAGE(PG8_SB(0, 0), cB, voffB); PG8_STAGE(PG8_SB(0, 1), cB + hstepB, voffB); PG8_STAGE(PG8_SA(0, 0), cA, voffA); PG8_STAGE(PG8_SA(0, 1), cA + hstepA, voffA);
    if (wr == 1) PG8_BAR;
    PG8_WAIT_V(2); PG8_BAR;
    PG8_STAGE(PG8_SB(1, 0), cB + kstep, voffB); PG8_STAGE(PG8_SA(1, 0), cA + kstep, voffA); PG8_STAGE(PG8_SB(1, 1), cB + hstepB + kstep, voffB);
    PG8_WAIT_V(6); PG8_BAR;
    for (;;) {
        const bool has_next = S.next(ui + 1, nxt);
        const char* nA = has_next ? (const char*)g.A + (size_t)nxt.pm * tstepA + (size_t)nxt.kt0 * kstep : cA; const char* nB = has_next ? (const char*)g.Bt + (size_t)nxt.pn * tstepB + (size_t)nxt.kt0 * kstep : cB;
        const int nt = cur.nkt;
        for (int t = 0; t < nt; t += 2) {
            const bool last = (t == nt - 2);
            const char* a1 = cA + (size_t)(t + 1) * kstep;
            const char* a2 = last ? nA : cA + (size_t)(t + 2) * kstep; const char* b2 = last ? nB : cB + (size_t)(t + 2) * kstep;
            const char* a3 = a2 + kstep; const char* b3 = b2 + kstep;
            if constexpr (Epi::HOOK_T > 0) { if (t == Epi::HOOK_T && nt == ntf) { E.mid(acc, cur, wr, wc, fr, fq); PG8_SCHED; } }
            PG8_LDB(B0, 0, 0); PG8_LDB(B1, 0, 1); PG8_SCHED; PG8_LDA(At, 0, 0); PG8_STAGE(PG8_SA(1, 1), a1 + hstepA, voffA);
            PG8_WAIT_V(8); PG8_WAIT_L(0); PG8_BAR; PG8_MMA(0, 0, At, B0); PG8_MMA(0, 1, At, B1); PG8_BAR; PG8_SCHED;
            PG8_LDA(At, 0, 1); PG8_STAGE(PG8_SB(0, 0), b2, voffB); PG8_STAGE(PG8_SB(0, 1), b2 + hstepB, voffB); PG8_STAGE(PG8_SA(0, 0), a2, voffA);
            PG8_WAIT_V(8); PG8_WAIT_L(0); PG8_BAR; PG8_MMA(1, 0, At, B0); PG8_MMA(1, 1, At, B1); PG8_BAR; PG8_SCHED;
            PG8_LDB(B0, 1, 0); PG8_LDB(B1, 1, 1); PG8_SCHED; PG8_LDA(At, 1, 0); PG8_STAGE(PG8_SA(0, 1), a2 + hstepA, voffA);
            PG8_WAIT_V(8); PG8_WAIT_L(0); PG8_BAR; PG8_MMA(0, 0, At, B0); PG8_MMA(0, 1, At, B1); PG8_BAR; PG8_SCHED;
            PG8_LDA(At, 1, 1); PG8_STAGE(PG8_SB(1, 0), b3, voffB); PG8_STAGE(PG8_SB(1, 1), b3 + hstepB, voffB); PG8_STAGE(PG8_SA(1, 0), a3, voffA);
            PG8_WAIT_V(8); PG8_WAIT_L(0); PG8_BAR; PG8_MMA(1, 0, At, B0); PG8_MMA(1, 1, At, B1); PG8_BAR; PG8_SCHED;
        }
        if (wr == 0) PG8_BAR;
        E(acc, cur, wr, wc, fr, fq);
        if (!has_next) break;
#pragma unroll
        for (int a = 0; a < 2; ++a)
#pragma unroll
            for (int b = 0; b < 2; ++b)
#pragma unroll
                for (int m = 0; m < 4; ++m)
#pragma unroll
                    for (int n = 0; n < 2; ++n) acc[a][b][m][n] = (f32x4){0.f, 0.f, 0.f, 0.f};
        cur = nxt; cA = nA; cB = nB; ++ui;
        if (wr == 1) PG8_BAR;
    }
    PG8_WAIT_V(0);
    PG8_BAR;
#undef PG8_SA
#undef PG8_SB
#undef PG8_STAGE
#undef PG8_LDA
#undef PG8_LDB
#undef PG8_MMA
#undef PG8_WAIT_V
#undef PG8_WAIT_L
#undef PG8_BAR
#undef PG8_SCHED
}
}
using pg8::Unit;

__device__ __forceinline__ void store8(bf16_t* p, const f32x4 v0, const f32x4 v1) {
    u32x4 w; w.x = cvt_pk_bf16(v0[0], v0[1]); w.y = cvt_pk_bf16(v0[2], v0[3]); w.z = cvt_pk_bf16(v1[0], v1[1]); w.w = cvt_pk_bf16(v1[2], v1[3]);
    *(u32x4*)p = w;
}
__device__ __forceinline__ void rs_store(const f32x4 (&acc)[2][2][4][2], int row0, int col, bf16_t* R, bf16_t* SC) {
#pragma unroll
    for (int ai = 0; ai < 2; ++ai)
#pragma unroll
        for (int m = 0; m < 4; ++m) { const int row = row0 + ai * 128 + m * 16;
            f32x4 r[2], s[2];
#pragma unroll
            for (int n = 0; n < 2; ++n)
#pragma unroll
                for (int j = 0; j < 4; ++j) { const float ea = __builtin_amdgcn_exp2f(acc[ai][0][m][n][j] * -1.4426950408889634f), eb = __builtin_amdgcn_exp2f(acc[ai][1][m][n][j] * -1.4426950408889634f);
                    s[n][j] = __builtin_amdgcn_rcpf(1.0f + eb); r[n][j] = (1.0f + eb) * __builtin_amdgcn_rcpf(1.0f + ea); }
            store8(R + (size_t)row * 1024 + col, r[0], r[1]); store8(SC + (size_t)row * 1024 + col, s[0], s[1]); }
}
template <int SUB> struct EpiIn {
    static constexpr bool PERM = true; static constexpr int HOOK_T = -1;
    bf16_t *Q, *Kb, *ACAT, *G, *U, *R, *SC; const float* rot;
    __device__ __forceinline__ void mid(f32x4 (&)[2][2][4][2], const Unit&, int, int, int, int) const {}
    __device__ __forceinline__ void operator()(const f32x4 (&acc)[2][2][4][2], const Unit& u, int wr, int wc, int fr, int fq) const {
        asm volatile("" : "+v"(fr), "+v"(fq));
        const int row0 = u.pm * 256 + wr * 64 + fr; const int cl = wc * 32 + 8 * fq;
        if constexpr (SUB == 0) {
            if (u.pn < 8) {
                bf16_t* base = (u.pn < 4) ? Q : Kb; const float sc = (u.pn < 4) ? 1.0f : 0.0625f; const int colt = (u.pn & 3) * 256;
#pragma unroll
                for (int ai = 0; ai < 2; ++ai)
#pragma unroll
                    for (int m = 0; m < 4; ++m) { const int row = row0 + ai * 128 + m * 16; const int pos = row_pos(row);
#pragma unroll
                        for (int bj = 0; bj < 2; ++bj) { const int c0 = bj * 128 + cl;
                            const f32x4* rp = (const f32x4*)(rot + ((size_t)pos * 128 + (c0 >> 1)) * 2);
                            const f32x4 t0 = rp[0], t1 = rp[1];
                            const f32x4 a = acc[ai][bj][m][0], b = acc[ai][bj][m][1];
                            f32x4 o0, o1;
                            o0[0] = (a[0] * t0[0] - a[1] * t0[1]) * sc; o0[1] = (a[0] * t0[1] + a[1] * t0[0]) * sc;
                            o0[2] = (a[2] * t0[2] - a[3] * t0[3]) * sc; o0[3] = (a[2] * t0[3] + a[3] * t0[2]) * sc;
                            o1[0] = (b[0] * t1[0] - b[1] * t1[1]) * sc; o1[1] = (b[0] * t1[1] + b[1] * t1[0]) * sc;
                            o1[2] = (b[2] * t1[2] - b[3] * t1[3]) * sc; o1[3] = (b[2] * t1[3] + b[3] * t1[2]) * sc;
                            store8(base + (size_t)row * 1024 + colt + c0, o0, o1); } }
            } else {
                const int colt = (u.pn - 8) * 256;
#pragma unroll
                for (int ai = 0; ai < 2; ++ai)
#pragma unroll
                    for (int m = 0; m < 4; ++m) { const int row = row0 + ai * 128 + m * 16;
#pragma unroll
                        for (int bj = 0; bj < 2; ++bj) store8(ACAT + (size_t)row * 3072 + colt + bj * 128 + cl, acc[ai][bj][m][0], acc[ai][bj][m][1]); }
            }
        } else if constexpr (SUB == 1) {
            if (u.pn >= 19) {
                rs_store(acc, row0 - T_PROMPT, (u.pn - 19) * 128 + cl, R, SC);
            } else if (u.pn < 11) {
                bf16_t* base; int ld;
                if (u.pn < 8) { base = G + u.pn * 256; ld = 2048; } else { base = ACAT + 2048 + (u.pn - 7) * 256; ld = 3072; }
#pragma unroll
                for (int ai = 0; ai < 2; ++ai)
#pragma unroll
                    for (int m = 0; m < 4; ++m) { const int row = row0 + ai * 128 + m * 16;
#pragma unroll
                        for (int bj = 0; bj < 2; ++bj) store8(base + (size_t)row * ld + bj * 128 + cl, acc[ai][bj][m][0], acc[ai][bj][m][1]); }
            } else {
                const int colt = (u.pn - 11) * 128;
#pragma unroll
                for (int ai = 0; ai < 2; ++ai)
#pragma unroll
                    for (int m = 0; m < 4; ++m) { const int row = row0 + ai * 128 + m * 16;
                        store8(U + (size_t)row * 1024 + colt + cl, acc[ai][0][m][0] * acc[ai][1][m][0], acc[ai][0][m][1] * acc[ai][1][m][1]); }
            }
        } else {
            rs_store(acc, row0, u.pn * 128 + cl, R, SC);
        }
    }
};
struct EpiMerged {
    static constexpr bool PERM = true; static constexpr int HOOK_T = 32;
    const bf16_t *R, *SC; bf16_t* O; float* MS32; const bf16_t *Rs, *SCs;
    __device__ __forceinline__ void mid(f32x4 (&acc)[2][2][4][2], const Unit& u, int wr, int wc, int fr, int fq) const {
        asm volatile("" : "+v"(fr), "+v"(fq));
        const int row0 = u.pm * 256 + wr * 64 + fr, col0 = u.pn * 256 + wc * 32 + 8 * fq;
#pragma unroll
        for (int ai = 0; ai < 2; ++ai)
#pragma unroll
            for (int m = 0; m < 4; ++m) { const int row = row0 + ai * 128 + m * 16;
#pragma unroll
                for (int bj = 0; bj < 2; ++bj) { const u32x4 w = *(const u32x4*)(R + (size_t)row * 1024 + col0 + bj * 128);
                    acc[ai][bj][m][0] *= (f32x4){bf_lo(w.x), bf_hi(w.x), bf_lo(w.y), bf_hi(w.y)}; acc[ai][bj][m][1] *= (f32x4){bf_lo(w.z), bf_hi(w.z), bf_lo(w.w), bf_hi(w.w)}; }
                asm volatile("" ::: "memory"); }
    }
    __device__ __forceinline__ void operator()(const f32x4 (&acc)[2][2][4][2], const Unit& u, int wr, int wc, int fr, int fq) const {
        asm volatile("" : "+v"(fr), "+v"(fq));
        const int row0 = u.pm * 256 + wr * 64 + fr, col0 = u.pn * 256 + wc * 32 + 8 * fq;
        if (u.nkt != 48) {
            const bool ret = u.kt0 < 32;
#pragma unroll
            for (int ai = 0; ai < 2; ++ai)
#pragma unroll
                for (int m = 0; m < 4; ++m) { const int row = row0 + ai * 128 + m * 16;
#pragma unroll
                    for (int bj = 0; bj < 2; ++bj) { const u32x4 w = *(const u32x4*)(SCs + (size_t)(row - T_PROMPT) * 1024 + col0 + bj * 128);
                        u32x4 rw = (u32x4){0x3f803f80u, 0x3f803f80u, 0x3f803f80u, 0x3f803f80u};
                        if (ret) rw = *(const u32x4*)(Rs + (size_t)(row - T_PROMPT) * 1024 + col0 + bj * 128);
                        float* dst = MS32 + (size_t)(u.kt0 >> 2) * (512 * 1024) + (size_t)(row - T_PROMPT) * 1024 + col0 + bj * 128;
                        const f32x4 g0 = (f32x4){bf_lo(w.x) * bf_lo(rw.x), bf_hi(w.x) * bf_hi(rw.x), bf_lo(w.y) * bf_lo(rw.y), bf_hi(w.y) * bf_hi(rw.y)};
                        const f32x4 g1 = (f32x4){bf_lo(w.z) * bf_lo(rw.z), bf_hi(w.z) * bf_hi(rw.z), bf_lo(w.w) * bf_lo(rw.w), bf_hi(w.w) * bf_hi(rw.w)};
                        *(f32x4*)dst = acc[ai][bj][m][0] * g0; *(f32x4*)(dst + 4) = acc[ai][bj][m][1] * g1; }
                    asm volatile("" ::: "memory"); }
            return;
        }
#pragma unroll
        for (int ai = 0; ai < 2; ++ai)
#pragma unroll
            for (int m = 0; m < 4; ++m) { const int row = row0 + ai * 128 + m * 16;
#pragma unroll
                for (int bj = 0; bj < 2; ++bj) { const u32x4 w = *(const u32x4*)(SC + (size_t)row * 1024 + col0 + bj * 128);
                    store8(O + (size_t)row * 1024 + col0 + bj * 128, acc[ai][bj][m][0] * (f32x4){bf_lo(w.x), bf_hi(w.x), bf_lo(w.y), bf_hi(w.y)},
                           acc[ai][bj][m][1] * (f32x4){bf_lo(w.z), bf_hi(w.z), bf_lo(w.w), bf_hi(w.w)}); }
                asm volatile("" ::: "memory"); }
    }
};
struct EpiOut {
    static constexpr bool PERM = false; static constexpr int HOOK_T = -1;
    const float *x_prompt, *x_sample, *lnst, *ln_g, *ln_b, *bias, *mod; float* Z; float* ZS;
    __device__ __forceinline__ void mid(f32x4 (&)[2][2][4][2], const Unit&, int, int, int, int) const {}
    __device__ __forceinline__ void operator()(const f32x4 (&acc)[2][2][4][2], const Unit& u, int wr, int wc, int fr, int fq) const {
        asm volatile("" : "+v"(fr), "+v"(fq));
        const int row0 = u.pm * 256 + wr * 64 + fr, col0 = u.pn * 256 + wc * 32 + 4 * fq;
#pragma unroll
        for (int ai = 0; ai < 2; ++ai)
#pragma unroll
            for (int m = 0; m < 4; ++m) { const int row = row0 + ai * 128 + m * 16; const int s = row_seq(row);
                const float* xr = row < T_PROMPT ? x_prompt + (size_t)row * 1024 : x_sample + (size_t)(row - T_PROMPT) * 1024;
                const float mu = lnst[2 * row], rstd = lnst[2 * row + 1];
                const float* gt = mod + (size_t)s * 6144 + 2048;
#pragma unroll
                for (int bj = 0; bj < 2; ++bj)
#pragma unroll
                    for (int n = 0; n < 2; ++n) { const int c = col0 + bj * 128 + n * 16;
                        const f32x4 xv = *(const f32x4*)(xr + c), gv = *(const f32x4*)(ln_g + c), bv = *(const f32x4*)(ln_b + c), bo = *(const f32x4*)(bias + c), gg = *(const f32x4*)(gt + c);
                        const f32x4 xl = (xv - mu) * rstd * gv + bv;
                        if (u.nkt != 16) { f32x4 v = gg * acc[ai][bj][m][n]; if (u.kt0 == 0) v += xl * ALPHA + gg * bo;
                            *(f32x4*)(ZS + (size_t)(u.kt0 >> 2) * (512 * 1024) + (size_t)(row - T_PROMPT) * 1024 + c) = v; }
                        else *(f32x4*)(Z + (size_t)row * 1024 + c) = xl * ALPHA + gg * (acc[ai][bj][m][n] + bo); }
                asm volatile("" ::: "memory"); }
    }
};
struct EpiUp {
    static constexpr bool PERM = true; static constexpr int HOOK_T = -1;
    bf16_t *AU, *GB;
    __device__ __forceinline__ void mid(f32x4 (&)[2][2][4][2], const Unit&, int, int, int, int) const {}
    __device__ __forceinline__ void operator()(const f32x4 (&acc)[2][2][4][2], const Unit& u, int wr, int wc, int fr, int fq) const {
        asm volatile("" : "+v"(fr), "+v"(fq));
        const int row0 = u.pm * 256 + wr * 64 + fr; const int cl = wc * 32 + 8 * fq;
        bf16_t* base = (u.pn < 11) ? AU + u.pn * 256 : GB + (u.pn - 11) * 256;
#pragma unroll
        for (int ai = 0; ai < 2; ++ai)
#pragma unroll
            for (int m = 0; m < 4; ++m) { const int row = row0 + ai * 128 + m * 16;
#pragma unroll
                for (int bj = 0; bj < 2; ++bj) store8(base + (size_t)row * DFF + bj * 128 + cl, acc[ai][bj][m][0], acc[ai][bj][m][1]); }
    }
};
struct EpiDown {
    static constexpr bool PERM = false; static constexpr int HOOK_T = -1;
    const bf16_t* X1; const float *bias, *mod; float* Z; float* ZS;
    __device__ __forceinline__ void mid(f32x4 (&)[2][2][4][2], const Unit&, int, int, int, int) const {}
    __device__ __forceinline__ void operator()(const f32x4 (&acc)[2][2][4][2], const Unit& u, int wr, int wc, int fr, int fq) const {
        asm volatile("" : "+v"(fr), "+v"(fq));
        const int row0 = u.pm * 256 + wr * 64 + fr, col0 = u.pn * 256 + wc * 32 + 4 * fq;
#pragma unroll
        for (int ai = 0; ai < 2; ++ai)
#pragma unroll
            for (int m = 0; m < 4; ++m) { const int row = row0 + ai * 128 + m * 16; const int s = row_seq(row);
                const float* gc = mod + (size_t)s * 6144 + 5120;
#pragma unroll
                for (int bj = 0; bj < 2; ++bj)
#pragma unroll
                    for (int n = 0; n < 2; ++n) { const int c = col0 + bj * 128 + n * 16;
                        const u32x2 xw = *(const u32x2*)(X1 + (size_t)row * 1024 + c); const f32x4 bo = *(const f32x4*)(bias + c), gg = *(const f32x4*)(gc + c);
                        const f32x4 x1 = (f32x4){bf_lo(xw.x), bf_hi(xw.x), bf_lo(xw.y), bf_hi(xw.y)};
                        if (u.nkt != 44) { f32x4 v = gg * acc[ai][bj][m][n]; if (u.kt0 == 0) v += x1 * ALPHA + gg * bo;
                            *(f32x4*)(ZS + (size_t)(u.kt0 >> 2) * (512 * 1024) + (size_t)(row - T_PROMPT) * 1024 + c) = v; }
                        else *(f32x4*)(Z + (size_t)row * 1024 + c) = x1 * ALPHA + gg * (acc[ai][bj][m][n] + bo); }
                asm volatile("" ::: "memory"); }
    }
};

__device__ __forceinline__ int win_src_col(int n) {
    if (n < 4096) return n;
    if (n < 4352) return 6144 + (n - 4096);
    if (n < 6400) return 4096 + (n - 4352);
    if (n < 7168) return 6144 + 256 + (n - 6400);
    const int base = n < 9216 ? 7168 : 9216; const int r = n - base, p = r >> 8, w = r & 255;
    return w < 128 ? base + 128 * p + w : base + 1024 + 128 * p + (w - 128);
}
__device__ __forceinline__ void transpose_item(const float* W, int N, int k0, int nsrc0, bf16_t* WT, int ldk, int drow0, int kofs, LAS float* scr, int lane) {
    float tv[32];
#pragma unroll
    for (int i = 0; i < 32; ++i) tv[i] = W[(size_t)(k0 + 2 * i + (lane >> 5)) * N + nsrc0 + (lane & 31)];
#pragma unroll
    for (int i = 0; i < 32; ++i) scr[(2 * i + (lane >> 5)) * 33 + (lane & 31)] = tv[i];
    asm volatile("s_waitcnt lgkmcnt(0)" ::: "memory");
    const int c = lane & 7;
#pragma unroll
    for (int j = 0; j < 4; ++j) { const int n = (lane >> 3) + 8 * j; const LAS float* s = scr + (8 * c) * 33 + n;
        u32x4 o; o.x = cvt_pk_bf16(s[0 * 33], s[1 * 33]); o.y = cvt_pk_bf16(s[2 * 33], s[3 * 33]); o.z = cvt_pk_bf16(s[4 * 33], s[5 * 33]); o.w = cvt_pk_bf16(s[6 * 33], s[7 * 33]);
        *(u32x4*)(WT + (size_t)(drow0 + n) * ldk + kofs + k0 + 8 * c) = o; }
    asm volatile("s_waitcnt lgkmcnt(0)" ::: "memory");
}
__device__ __forceinline__ void phase0(const Params& p, LAS unsigned char* lds) {
    const int tid = threadIdx.x, wave = __builtin_amdgcn_readfirstlane(tid >> 6), lane = tid & 63;
    const int gw = blockIdx.x * 8 + wave, NGW = gridDim.x * 8;
    unsigned char* ws = p.ws;
    LAS float* scr = (LAS float*)(lds + wave * 8704);
    float* modp = (float*)(ws + OFF_MODP);
    constexpr int I_MOD = 1536, I_IN = 16 * 352, I_ORET = 32 * 32, I_OCONV = 16 * 32, I_OUT = 16 * 32, I_UP = 16 * 176, I_DOWN = 44 * 32;
    constexpr int NITEMS = I_MOD + I_IN + I_ORET + I_OCONV + I_OUT + I_UP + I_DOWN;
    for (int it = gw; it < NITEMS; it += NGW) {
        int r = it;
        if (r < I_MOD) {
            const int cgp = r % 96, kc = r / 96, n = cgp * 64 + lane, kb = kc * 64;
            float a[32];
#pragma unroll
            for (int s = 0; s < 32; ++s) a[s] = 0.f;
#pragma unroll 1
            for (int kq = 0; kq < 64; kq += 16) {
                float w[16];
#pragma unroll
                for (int j = 0; j < 16; ++j) w[j] = p.w_mod[(size_t)(kb + kq + j) * 6144 + n];
#pragma unroll
                for (int k = 0; k < 16; k += 4) {
#pragma unroll
                    for (int s = 0; s < 32; ++s) { const float* cp = (s < 16 ? p.c_prompt + s * 1024 : p.c_sample + (s - 16) * 1024) + kb + kq + k; const f32x4 cv = *(const f32x4*)cp;
                        a[s] += cv[0] * w[k] + cv[1] * w[k + 1] + cv[2] * w[k + 2] + cv[3] * w[k + 3]; }
                }
            }
#pragma unroll
            for (int s = 0; s < 32; ++s) modp[((size_t)kc * 32 + s) * 6144 + n] = a[s];
            continue;
        }
        r -= I_MOD;
        const float* W; int N, k0, nsrc0, ldk, drow0, kofs; bf16_t* WT;
        if (r < I_IN) { const int kb = r / 352, nb = r % 352; W = p.w_in; N = 11264; k0 = kb * 64; nsrc0 = win_src_col(nb * 32); WT = (bf16_t*)(ws + OFF_WIN); ldk = 1024; drow0 = nb * 32; kofs = 0; }
        else { r -= I_IN;
        if (r < I_ORET) { const int kb = r / 32, nb = r % 32; W = p.w_o_ret; N = 1024; k0 = kb * 64; nsrc0 = nb * 32; WT = (bf16_t*)(ws + OFF_WCAT); ldk = 3072; drow0 = nb * 32; kofs = 0; }
        else { r -= I_ORET;
        if (r < I_OCONV) { const int kb = r / 32, nb = r % 32; W = p.w_o_conv; N = 1024; k0 = kb * 64; nsrc0 = nb * 32; WT = (bf16_t*)(ws + OFF_WCAT); ldk = 3072; drow0 = nb * 32; kofs = 2048; }
        else { r -= I_OCONV;
        if (r < I_OUT) { const int kb = r / 32, nb = r % 32; W = p.w_out; N = 1024; k0 = kb * 64; nsrc0 = nb * 32; WT = (bf16_t*)(ws + OFF_WOUT); ldk = 1024; drow0 = nb * 32; kofs = 0; }
        else { r -= I_OUT;
        if (r < I_UP) { const int kb = r / 176, nb = r % 176; W = p.w_up; N = 5632; k0 = kb * 64; nsrc0 = nb * 32; WT = (bf16_t*)(ws + OFF_WUP); ldk = 1024; drow0 = nb * 32; kofs = 0; }
        else { r -= I_UP; const int kb = r / 32, nb = r % 32; W = p.w_down; N = 1024; k0 = kb * 64; nsrc0 = nb * 32; WT = (bf16_t*)(ws + OFF_WDOWN); ldk = 2816; drow0 = nb * 32; kofs = 0; } } } } }
        transpose_item(W, N, k0, nsrc0, WT, ldk, drow0, kofs, scr, lane);
    }
    float* rot = (float*)(ws + OFF_ROT);
    for (int idx = blockIdx.x * 512 + tid; idx < 2080 * 128; idx += gridDim.x * 512) {
        const int pos = idx >> 7, i = idx & 127;
        const float invf = exp2f(-(float)i * (13.287712379549449f / 128.0f));
        double rev = (double)pos * (double)invf * 0.15915494309189535; rev -= rint(rev);
        const float f = (float)rev;
        rot[2 * idx] = __builtin_amdgcn_cosf(f); rot[2 * idx + 1] = __builtin_amdgcn_sinf(f);
    }
}

__device__ __forceinline__ void phase1(const Params& p, LAS unsigned char* lds) {
    const int tid = threadIdx.x, wave = tid >> 6, lane = tid & 63;
    unsigned char* ws = p.ws;
    const float* modp = (const float*)(ws + OFF_MODP); float* mod = (float*)(ws + OFF_MOD); float* lnst = (float*)(ws + OFF_LNST);
    bf16_t* H = (bf16_t*)p.out;
    for (int i = blockIdx.x * 512 + tid; i < 32 * 6144; i += gridDim.x * 512) { const int n = i % 6144; float v = p.b_mod[n];
#pragma unroll
        for (int kc = 0; kc < 16; ++kc) v += modp[(size_t)kc * 32 * 6144 + i];
        mod[i] = v; }
    LAS float* lm = (LAS float*)lds;
    int s_have = -1;
    for (int grp = (int)(((long)blockIdx.x * 1040) / gridDim.x), gend = (int)(((long)(blockIdx.x + 1) * 1040) / gridDim.x); grp < gend; ++grp) {
        const int s = grp < 1024 ? (grp >> 6) : 16 + (grp - 1024);
        if (s != s_have) {
#pragma unroll
            for (int j = 0; j < 4; ++j) { const int idx = tid + 512 * j; float v = p.b_mod[idx];
#pragma unroll
                for (int kc = 0; kc < 16; ++kc) v += modp[((size_t)kc * 32 + s) * 6144 + idx];
                lm[idx] = v; }
            s_have = s;
        }
        __syncthreads();
        {
            const int rowb = grp * 32 + wave * 4;
            f32x4 v[4][4]; float mean[4], rstd[4];
#pragma unroll
            for (int rr = 0; rr < 4; ++rr) { const int row = rowb + rr;
                const float* xr = row < T_PROMPT ? p.x_prompt + (size_t)row * 1024 : p.x_sample + (size_t)(row - T_PROMPT) * 1024;
#pragma unroll
                for (int j = 0; j < 4; ++j) v[rr][j] = ((const f32x4*)xr)[lane + 64 * j]; }
#pragma unroll
            for (int rr = 0; rr < 4; ++rr) { float sm = 0.f;
#pragma unroll
                for (int j = 0; j < 4; ++j) sm += (v[rr][j][0] + v[rr][j][1]) + (v[rr][j][2] + v[rr][j][3]);
                mean[rr] = wave_sum(sm) * (1.0f / 1024.0f); float s2 = 0.f;
#pragma unroll
                for (int j = 0; j < 4; ++j) { v[rr][j] = v[rr][j] - mean[rr]; s2 += (v[rr][j][0] * v[rr][j][0] + v[rr][j][1] * v[rr][j][1]) + (v[rr][j][2] * v[rr][j][2] + v[rr][j][3] * v[rr][j][3]); }
                rstd[rr] = 1.0f / sqrtf(wave_sum(s2) * (1.0f / 1024.0f) + LN_EPS); }
#pragma unroll
            for (int j = 0; j < 4; ++j) { const int c = 4 * (lane + 64 * j);
                const f32x4 gv = *(const f32x4*)(p.ln_in_g + c), bv = *(const f32x4*)(p.ln_in_b + c);
                const f32x4 sh = *(const LAS f32x4*)(lm + c), sc = *(const LAS f32x4*)(lm + 1024 + c);
#pragma unroll
                for (int rr = 0; rr < 4; ++rr) { const f32x4 xl = v[rr][j] * rstd[rr] * gv + bv; const f32x4 h = xl * (sc + 1.0f) + sh;
                    u32x2 w; w.x = cvt_pk_bf16(h[0], h[1]); w.y = cvt_pk_bf16(h[2], h[3]);
                    *(u32x2*)(H + (size_t)(rowb + rr) * 1024 + c) = w; } }
            if (lane < 4) { lnst[2 * (rowb + lane)] = lane == 0 ? mean[0] : lane == 1 ? mean[1] : lane == 2 ? mean[2] : mean[3];
                            lnst[2 * (rowb + lane) + 1] = lane == 0 ? rstd[0] : lane == 1 ? rstd[1] : lane == 2 ? rstd[2] : rstd[3]; }
        }
        __syncthreads();
    }
}

constexpr int RT_QS = 264, RT_TS = 72;
#define LDS_BARRIER() do { asm volatile("s_waitcnt lgkmcnt(0)" ::: "memory"); __builtin_amdgcn_s_barrier(); asm volatile("" ::: "memory"); } while (0)
__device__ __forceinline__ void phase_retention(const Params& p, LAS unsigned char* lds, const bool dry) {
    const int tid0 = threadIdx.x, w = __builtin_amdgcn_readfirstlane(tid0 >> 6), l0 = tid0 & 63;
    unsigned char* ws = p.ws;
    const bf16_t* Qg = (const bf16_t*)(ws + OFF_Q); const bf16_t* Kg = (const bf16_t*)(ws + OFF_K);
    bf16_t* ACAT = (bf16_t*)(ws + OFF_ACAT); float* rst = (float*)(ws + OFF_RST);
    LAS bf16_t* Qn = (LAS bf16_t*)lds; LAS bf16_t* Kn = Qn + 64 * RT_QS; LAS bf16_t* KT = Kn + 64 * RT_QS;
    LAS bf16_t* VT = KT + 256 * RT_TS; LAS bf16_t* Pm = VT + 128 * RT_TS; LAS float* red = (LAS float*)(Pm + 64 * RT_TS);
    for (int item = blockIdx.x; item < 512; item += gridDim.x) {
        const bool samp = item >= 256; const int it = item & 255, xcd = it & 7, slot = it >> 3, sl = slot & 3, pr = (slot >> 2) * 8 + xcd, b = pr >> 2, h = pr & 3;
        const int Lc = samp ? 32 : 64, nch = samp ? 1 : 32;
        const size_t row0 = samp ? (size_t)(T_PROMPT + b * 32) : (size_t)b * 2048;
        const float lg2 = log2f(1.0f - exp2f(-5.0f - (float)h));
        const int ecol = h * 512 + sl * 128;
        f32x4 S[16];
        { const int l = l0, fr = l & 15, g = l >> 4;
        if (samp) { const float* sp = p.state_ret + ((size_t)(b * 4 + h) * 256) * 512 + sl * 128 + 16 * w + fr;
#pragma unroll
            for (int T = 0; T < 16; ++T)
#pragma unroll
                for (int i = 0; i < 4; ++i) S[T][i] = sp[(size_t)(16 * T + 4 * g + i) * 512];
        } else {
#pragma unroll
            for (int T = 0; T < 16; ++T) S[T] = (f32x4){0.f, 0.f, 0.f, 0.f};
        } }
        u32x4 rq[4], rk[4], rv[2];
#define RT_IDX int l = l0; asm volatile("" : "+v"(l)); const int tid = w * 64 + l, fr = l & 15, g = l >> 4; \
        const int k_dc = w * 4 + (l & 3), k_tpl = (l >> 2) & 15; const int v_ec = (w & 3) * 4 + (l & 3), v_tp = (w >> 2) * 16 + ((l >> 2) & 15); (void)tid; (void)fr; (void)g; (void)k_dc; (void)k_tpl; (void)v_ec; (void)v_tp;
#define RT_LOAD(c) do { const size_t rb = row0 + (size_t)(c) * 64; \
            _Pragma("unroll") for (int j = 0; j < 4; ++j) { const int idx = tid + 512 * j, tok = idx >> 5, ch = idx & 31; \
                rq[j] = tok < Lc ? *(const u32x4*)(Qg + (rb + tok) * 1024 + h * 256 + ch * 8) : (u32x4){0u, 0u, 0u, 0u}; } \
            _Pragma("unroll") for (int j = 0; j < 2; ++j) { const int t0 = 2 * (j * 16 + k_tpl); \
                rk[2 * j] = t0 < Lc ? *(const u32x4*)(Kg + (rb + t0) * 1024 + h * 256 + k_dc * 8) : (u32x4){0u, 0u, 0u, 0u}; \
                rk[2 * j + 1] = t0 + 1 < Lc ? *(const u32x4*)(Kg + (rb + t0 + 1) * 1024 + h * 256 + k_dc * 8) : (u32x4){0u, 0u, 0u, 0u}; } \
            { const int t0 = 2 * v_tp; \
              rv[0] = t0 < Lc ? *(const u32x4*)(ACAT + (rb + t0) * 3072 + ecol + v_ec * 8) : (u32x4){0u, 0u, 0u, 0u}; \
              rv[1] = t0 + 1 < Lc ? *(const u32x4*)(ACAT + (rb + t0 + 1) * 3072 + ecol + v_ec * 8) : (u32x4){0u, 0u, 0u, 0u}; } } while (0)
        { RT_IDX RT_LOAD(0); }
        const float sdec = exp2f(lg2 * (float)Lc);
        for (int c = 0; c < nch; ++c) {
            RT_IDX
            LDS_BARRIER();
#pragma unroll
            for (int j = 0; j < 4; ++j) { const int idx = tid + 512 * j, tok = idx >> 5, ch = idx & 31; *(LAS u32x4*)(Qn + tok * RT_QS + ch * 8) = rq[j]; }
#pragma unroll
            for (int j = 0; j < 2; ++j) { const int tp = j * 16 + k_tpl, t0 = 2 * tp;
                *(LAS u32x4*)(Kn + t0 * RT_QS + k_dc * 8) = rk[2 * j]; *(LAS u32x4*)(Kn + (t0 + 1) * RT_QS + k_dc * 8) = rk[2 * j + 1];
                const float f0 = exp2f(lg2 * (float)(Lc - 1 - t0)), f1 = exp2f(lg2 * (float)(Lc - 2 - t0));
#pragma unroll
                for (int q = 0; q < 4; ++q) { const unsigned a = rk[2 * j][q], bb = rk[2 * j + 1][q];
                    *(LAS unsigned*)(KT + (k_dc * 8 + 2 * q) * RT_TS + t0) = cvt_pk_bf16(bf_lo(a) * f0, bf_lo(bb) * f1);
                    *(LAS unsigned*)(KT + (k_dc * 8 + 2 * q + 1) * RT_TS + t0) = cvt_pk_bf16(bf_hi(a) * f0, bf_hi(bb) * f1); } }
            { const int t0 = 2 * v_tp;
#pragma unroll
                for (int q = 0; q < 4; ++q) { const unsigned a = rv[0][q], bb = rv[1][q];
                    *(LAS unsigned*)(VT + (v_ec * 8 + 2 * q) * RT_TS + t0) = (a & 0xffffu) | (bb << 16);
                    *(LAS unsigned*)(VT + (v_ec * 8 + 2 * q + 1) * RT_TS + t0) = (a >> 16) | (bb & 0xffff0000u); } }
            if (c + 1 < nch) RT_LOAD(c + 1);
            LDS_BARRIER();
            { const int qi = w >> 1;
#pragma unroll
                for (int tj = 0; tj < 2; ++tj) { const int kj = (w & 1) * 2 + tj; f32x4 d = (f32x4){0.f, 0.f, 0.f, 0.f};
                    if (kj <= qi) {
#pragma unroll
                        for (int ks = 0; ks < 8; ++ks) { const bf16x8 af = *(const LAS bf16x8*)(Kn + (16 * kj + fr) * RT_QS + 32 * ks + 8 * g);
                            const bf16x8 bfv = *(const LAS bf16x8*)(Qn + (16 * qi + fr) * RT_QS + 32 * ks + 8 * g);
                            d = __builtin_amdgcn_mfma_f32_16x16x32_bf16(af, bfv, d, 0, 0, 0); }
                    }
                    const int qq = 16 * qi + fr, k0 = 16 * kj + 4 * g; float o[4];
#pragma unroll
                    for (int i = 0; i < 4; ++i) { const int dk = qq - (k0 + i); o[i] = dk >= 0 ? d[i] * exp2f(lg2 * (float)dk) : 0.f; }
                    u32x2 pw; pw.x = cvt_pk_bf16(o[0], o[1]); pw.y = cvt_pk_bf16(o[2], o[3]);
                    *(LAS u32x2*)(Pm + qq * RT_TS + k0) = pw; } }
            LDS_BARRIER();
            bf16x8 Bv[2];
#pragma unroll
            for (int ks = 0; ks < 2; ++ks) Bv[ks] = *(const LAS bf16x8*)(VT + (16 * w + fr) * RT_TS + 32 * ks + 8 * g);
            f32x4 oacc[4];
#pragma unroll
            for (int mi = 0; mi < 4; ++mi) oacc[mi] = (f32x4){0.f, 0.f, 0.f, 0.f};
            {
                u32x2 qb[2][4][2];
#pragma unroll
                for (int mi = 0; mi < 4; ++mi) { qb[0][mi][0] = *(const LAS u32x2*)(Qn + (16 * mi + fr) * RT_QS + 4 * g); qb[0][mi][1] = *(const LAS u32x2*)(Qn + (16 * mi + fr) * RT_QS + 16 + 4 * g); }
#pragma unroll
                for (int ks = 0; ks < 8; ++ks) {
                    if (ks + 1 < 8) {
#pragma unroll
                        for (int mi = 0; mi < 4; ++mi) { qb[(ks + 1) & 1][mi][0] = *(const LAS u32x2*)(Qn + (16 * mi + fr) * RT_QS + 32 * (ks + 1) + 4 * g);
                            qb[(ks + 1) & 1][mi][1] = *(const LAS u32x2*)(Qn + (16 * mi + fr) * RT_QS + 32 * (ks + 1) + 16 + 4 * g); } }
                    union { bf16x8 v; unsigned u[4]; } sb;
                    sb.u[0] = cvt_pk_bf16(S[2 * ks][0], S[2 * ks][1]); sb.u[1] = cvt_pk_bf16(S[2 * ks][2], S[2 * ks][3]);
                    sb.u[2] = cvt_pk_bf16(S[2 * ks + 1][0], S[2 * ks + 1][1]); sb.u[3] = cvt_pk_bf16(S[2 * ks + 1][2], S[2 * ks + 1][3]);
#pragma unroll
                    for (int mi = 0; mi < 4; ++mi) { union { bf16x8 v; u32x2 h2[2]; } qa; qa.h2[0] = qb[ks & 1][mi][0]; qa.h2[1] = qb[ks & 1][mi][1];
                        oacc[mi] = __builtin_amdgcn_mfma_f32_16x16x32_bf16(qa.v, sb.v, oacc[mi], 0, 0, 0); }
                }
            }
#pragma unroll
            for (int mi = 0; mi < 4; ++mi)
#pragma unroll
                for (int i = 0; i < 4; ++i) oacc[mi][i] *= exp2f(lg2 * (float)(16 * mi + 4 * g + i + 1));
#pragma unroll
            for (int mi = 0; mi < 4; ++mi) {
#pragma unroll
                for (int ks = 0; ks < 2; ++ks) { const bf16x8 af = *(const LAS bf16x8*)(Pm + (16 * mi + fr) * RT_TS + 32 * ks + 8 * g);
                    oacc[mi] = __builtin_amdgcn_mfma_f32_16x16x32_bf16(af, Bv[ks], oacc[mi], 0, 0, 0); }
            }
            __builtin_amdgcn_sched_barrier(0);
#pragma unroll
            for (int mi = 0; mi < 4; ++mi)
#pragma unroll
                for (int i = 0; i < 4; ++i) Kn[(16 * mi + 4 * g + i) * 136 + 16 * w + fr] = (bf16_t)(cvt_pk_bf16(oacc[mi][i], 0.f) & 0xffffu);
            __builtin_amdgcn_sched_barrier(0);
            {
                bf16x8 kf[2][2];
#pragma unroll
                for (int ks = 0; ks < 2; ++ks) kf[0][ks] = *(const LAS bf16x8*)(KT + fr * RT_TS + 32 * ks + 8 * g);
#pragma unroll
                for (int T = 0; T < 16; ++T) {
                    if (T + 1 < 16) {
#pragma unroll
                        for (int ks = 0; ks < 2; ++ks) kf[(T + 1) & 1][ks] = *(const LAS bf16x8*)(KT + (16 * (T + 1) + fr) * RT_TS + 32 * ks + 8 * g); }
                    S[T] *= sdec;
#pragma unroll
                    for (int ks = 0; ks < 2; ++ks) S[T] = __builtin_amdgcn_mfma_f32_16x16x32_bf16(kf[T & 1][ks], Bv[ks], S[T], 0, 0, 0);
                }
            }
            LDS_BARRIER();
            { const int q = tid >> 3, seg = tid & 7;
              const u32x4 v0 = *(const LAS u32x4*)(Kn + q * 136 + 16 * seg), v1 = *(const LAS u32x4*)(Kn + q * 136 + 16 * seg + 8);
              float s1 = 0.f, s2 = 0.f;
#pragma unroll
              for (int e = 0; e < 4; ++e) { const float a0 = bf_lo(v0[e]), a1 = bf_hi(v0[e]), b0 = bf_lo(v1[e]), b1 = bf_hi(v1[e]);
                  s1 += (a0 + a1) + (b0 + b1); s2 += (a0 * a0 + a1 * a1) + (b0 * b0 + b1 * b1); }
#pragma unroll
              for (int off = 1; off < 8; off <<= 1) { s1 += __shfl_xor(s1, off); s2 += __shfl_xor(s2, off); }
              if (q < Lc && !dry) { const size_t row = row0 + (size_t)c * 64 + q;
                  bf16_t* op = ACAT + row * 3072 + ecol + 16 * seg; *(u32x4*)op = v0; *(u32x4*)(op + 8) = v1;
                  if (seg == 0) { float* dst = rst + ((row * 4 + h) * 4 + sl) * 2; dst[0] = s1; dst[1] = s2; } } }
        }
#undef RT_LOAD
#undef RT_IDX
        { const int l = l0, fr = l & 15, g = l >> 4; float* so = p.out + (samp ? OUT_RETS : OUT_RETP) + ((size_t)(b * 4 + h) * 256) * 512 + sl * 128 + 16 * w + fr;
#pragma unroll
            for (int T = 0; T < 16; ++T)
#pragma unroll
                for (int i = 0; i < 4; ++i) if (!dry) so[(size_t)(16 * T + 4 * g + i) * 512] = S[T][i]; }
    }
}

__device__ __forceinline__ void unpack8(const u32x4 w, float (&f)[8]) {
#pragma unroll
    for (int q = 0; q < 4; ++q) { f[2 * q] = bf_lo(w[q]); f[2 * q + 1] = bf_hi(w[q]); }
}
__device__ __forceinline__ void phase_mix_elem(const Params& p, const bool dry) {
    unsigned char* ws = p.ws;
    bf16_t* ACAT = (bf16_t*)(ws + OFF_ACAT); const bf16_t* G = (const bf16_t*)(ws + OFF_G); const bf16_t* U = (const bf16_t*)(ws + OFF_U);
    const float* rst = (const float*)(ws + OFF_RST);
    const int gt = blockIdx.x * 512 + threadIdx.x; const int NS = (gridDim.x * 512) / 384; const int stream = gt / 384, cc = gt % 384;
    if (stream >= NS) return;
    const int rows_per = (T_ALL + NS - 1) / NS; const int r0 = stream * rows_per; const int r1 = min(r0 + rows_per, T_ALL);
    if (cc < 256) {
        const int j = cc >> 6, col = 8 * cc;
        for (int rb = r0; rb < r1; rb += 4) {
            u32x4 ov[4], gv[4]; f32x4 sa[4], sb[4];
#pragma unroll
            for (int i = 0; i < 4; ++i) { const int row = min(rb + i, r1 - 1);
                ov[i] = *(const u32x4*)(ACAT + (size_t)row * 3072 + col); gv[i] = *(const u32x4*)(G + (size_t)row * 2048 + col);
                const float* st = rst + ((size_t)row * 4 + j) * 8; sa[i] = *(const f32x4*)st; sb[i] = *(const f32x4*)(st + 4); }
#pragma unroll
            for (int i = 0; i < 4; ++i) { const int row = rb + i;
                const float s1 = (sa[i][0] + sa[i][2]) + (sb[i][0] + sb[i][2]), s2 = (sa[i][1] + sa[i][3]) + (sb[i][1] + sb[i][3]);
                const float mu = s1 * (1.0f / 512.0f); const float var = fmaxf(s2 * (1.0f / 512.0f) - mu * mu, 0.f); const float rstd = 1.0f / sqrtf(var + LN_EPS);
                u32x4 r;
#pragma unroll
                for (int q = 0; q < 4; ++q) { const float g0 = bf_lo(gv[i][q]), g1 = bf_hi(gv[i][q]);
                    const float a0 = g0 * sigmoidf_(g0) * ((bf_lo(ov[i][q]) - mu) * rstd), a1 = g1 * sigmoidf_(g1) * ((bf_hi(ov[i][q]) - mu) * rstd);
                    r[q] = cvt_pk_bf16(a0, a1); }
                if (row < r1 && !dry) *(u32x4*)(ACAT + (size_t)row * 3072 + col) = r; }
        }
    } else {
        const int c = 8 * (cc - 256);
        float cb[8], w0[8], w1[8], w2[8], um1[8], um2[8];
#pragma unroll
        for (int e = 0; e < 8; ++e) { cb[e] = p.conv_b[c + e]; w0[e] = p.conv_w[c + e]; w1[e] = p.conv_w[1024 + c + e]; w2[e] = p.conv_w[2048 + c + e]; um1[e] = 0.f; um2[e] = 0.f; }
        { const int row = r0; const bool samp = row >= T_PROMPT; const int t = samp ? ((row - T_PROMPT) & 31) : (row & 2047); const int bl = samp ? ((row - T_PROMPT) >> 5) : (row >> 11);
          if (t >= 1) unpack8(*(const u32x4*)(U + (size_t)(row - 1) * 1024 + c), um1);
          if (t >= 2) unpack8(*(const u32x4*)(U + (size_t)(row - 2) * 1024 + c), um2);
          else if (t == 1 && samp) {
#pragma unroll
              for (int e = 0; e < 8; ++e) um2[e] = p.state_conv[((size_t)bl * 2 + 1) * 1024 + c + e]; } }
        for (int rb = r0; rb < r1; rb += 4) {
            u32x4 bg[4], uv[4];
#pragma unroll
            for (int i = 0; i < 4; ++i) { const int row = min(rb + i, r1 - 1);
                bg[i] = *(const u32x4*)(ACAT + (size_t)row * 3072 + 2048 + c); uv[i] = *(const u32x4*)(U + (size_t)row * 1024 + c); }
#pragma unroll
            for (int i = 0; i < 4; ++i) { const int row = rb + i;
                if (row < r1) {
                    const bool samp = row >= T_PROMPT; const int t = samp ? ((row - T_PROMPT) & 31) : (row & 2047); const int L = samp ? 32 : 2048; const int bl = samp ? ((row - T_PROMPT) >> 5) : (row >> 11);
                    if (t == 0) {
#pragma unroll
                        for (int e = 0; e < 8; ++e) { um1[e] = samp ? p.state_conv[((size_t)bl * 2 + 1) * 1024 + c + e] : 0.f; um2[e] = samp ? p.state_conv[((size_t)bl * 2) * 1024 + c + e] : 0.f; } }
                    float uc[8], bgf[8], res[8]; unpack8(uv[i], uc); unpack8(bg[i], bgf);
#pragma unroll
                    for (int e = 0; e < 8; ++e) { res[e] = bgf[e] * (cb[e] + w0[e] * um2[e] + w1[e] * um1[e] + w2[e] * uc[e]); um2[e] = um1[e]; um1[e] = uc[e]; }
                    if (!dry) { u32x4 r; r.x = cvt_pk_bf16(res[0], res[1]); r.y = cvt_pk_bf16(res[2], res[3]); r.z = cvt_pk_bf16(res[4], res[5]); r.w = cvt_pk_bf16(res[6], res[7]);
                        *(u32x4*)(ACAT + (size_t)row * 3072 + 2048 + c) = r;
                        if (t >= L - 2) { float* so = p.out + (samp ? OUT_CONVS : OUT_CONVP) + ((size_t)bl * 2 + (t - (L - 2))) * 1024 + c;
                            *(f32x4*)so = (f32x4){uc[0], uc[1], uc[2], uc[3]}; *(f32x4*)(so + 4) = (f32x4){uc[4], uc[5], uc[6], uc[7]}; } }
                } }
        }
    }
}

__device__ __forceinline__ void phase_ln1(const Params& p, const bool dry) {
    const int tid = threadIdx.x, wave = tid >> 6, lane = tid & 63;
    unsigned char* ws = p.ws;
    const float* mod = (const float*)(ws + OFF_MOD); bf16_t* X1 = (bf16_t*)(ws + OFF_X1);
    for (int rowb = (blockIdx.x * 8 + wave) * 4; rowb < T_ALL; rowb += gridDim.x * 32) {
        const int s = row_seq(rowb);
        f32x4 v[4][4]; float rstd[4];
#pragma unroll
        for (int rr = 0; rr < 4; ++rr)
#pragma unroll
            for (int j = 0; j < 4; ++j) {
                if (rowb < T_PROMPT) v[rr][j] = ((const f32x4*)(p.out + (size_t)(rowb + rr) * 1024))[lane + 64 * j];
                else { const float* zs = (const float*)(ws + OFF_MS32) + (size_t)(rowb + rr - T_PROMPT) * 1024;
                    v[rr][j] = (((const f32x4*)zs)[lane + 64 * j] + ((const f32x4*)(zs + 512 * 1024))[lane + 64 * j]) + (((const f32x4*)(zs + 2 * 512 * 1024))[lane + 64 * j] + ((const f32x4*)(zs + 3 * 512 * 1024))[lane + 64 * j]); } }
#pragma unroll
        for (int rr = 0; rr < 4; ++rr) { float sm = 0.f;
#pragma unroll
            for (int j = 0; j < 4; ++j) sm += (v[rr][j][0] + v[rr][j][1]) + (v[rr][j][2] + v[rr][j][3]);
            const float mean = wave_sum(sm) * (1.0f / 1024.0f); float s2 = 0.f;
#pragma unroll
            for (int j = 0; j < 4; ++j) { v[rr][j] = v[rr][j] - mean; s2 += (v[rr][j][0] * v[rr][j][0] + v[rr][j][1] * v[rr][j][1]) + (v[rr][j][2] * v[rr][j][2] + v[rr][j][3] * v[rr][j][3]); }
            rstd[rr] = 1.0f / sqrtf(wave_sum(s2) * (1.0f / 1024.0f) + LN_EPS); }
#pragma unroll
        for (int j = 0; j < 4; ++j) { const int c = 4 * (lane + 64 * j);
            const f32x4 gv = *(const f32x4*)(p.ln1_g + c), bv = *(const f32x4*)(p.ln1_b + c);
            const f32x4 sh = *(const f32x4*)(mod + (size_t)s * 6144 + 3072 + c), sc = *(const f32x4*)(mod + (size_t)s * 6144 + 4096 + c);
#pragma unroll
            for (int rr = 0; rr < 4; ++rr) { const int row = rowb + rr;
                const f32x4 x1 = v[rr][j] * rstd[rr] * gv + bv; const f32x4 hh = x1 * (sc + 1.0f) + sh;
                u32x2 w; w.x = cvt_pk_bf16(x1[0], x1[1]); w.y = cvt_pk_bf16(x1[2], x1[3]);
                u32x2 w2; w2.x = cvt_pk_bf16(hh[0], hh[1]); w2.y = cvt_pk_bf16(hh[2], hh[3]);
                if (!dry) { *(u32x2*)(X1 + (size_t)row * 1024 + c) = w; *(u32x2*)((bf16_t*)p.out + (size_t)row * 2048 + c) = w2; } } }
    }
}

__device__ __forceinline__ void phase_ffn_elem(const Params& p, const bool dry) {
    unsigned char* ws = p.ws;
    const bf16_t* AU = (const bf16_t*)(ws + OFF_AU); bf16_t* GBF = (bf16_t*)(ws + OFF_GBF);
    const int gt = blockIdx.x * 512 + threadIdx.x; const int NS = (gridDim.x * 512) / 352; const int stream = gt / 352, cc = gt % 352;
    if (stream >= NS) return;
    const int rows_per = (T_ALL + NS - 1) / NS; const int r0 = stream * rows_per; const int r1 = min(r0 + rows_per, T_ALL);
    if (r0 >= r1) return;
    const int c = 8 * cc;
    float cb[8], w0[8], w1[8], w2[8], am1[8], am2[8];
#pragma unroll
    for (int e = 0; e < 8; ++e) { cb[e] = p.ffn_conv_b[c + e]; w0[e] = p.ffn_conv_w[c + e]; w1[e] = p.ffn_conv_w[DFF + c + e]; w2[e] = p.ffn_conv_w[2 * DFF + c + e]; am1[e] = 0.f; am2[e] = 0.f; }
    { const int row = r0; const bool samp = row >= T_PROMPT; const int t = samp ? ((row - T_PROMPT) & 31) : (row & 2047); const int bl = samp ? ((row - T_PROMPT) >> 5) : (row >> 11);
      if (t >= 1) unpack8(*(const u32x4*)(AU + (size_t)(row - 1) * DFF + c), am1);
      if (t >= 2) unpack8(*(const u32x4*)(AU + (size_t)(row - 2) * DFF + c), am2);
      else if (t == 1 && samp) {
#pragma unroll
          for (int e = 0; e < 8; ++e) am2[e] = p.state_ffn[((size_t)bl * 2 + 1) * DFF + c + e]; } }
    for (int rb = r0; rb < r1; rb += 4) {
        u32x4 av[4], gv[4];
#pragma unroll
        for (int i = 0; i < 4; ++i) { const int row = min(rb + i, r1 - 1);
            av[i] = *(const u32x4*)(AU + (size_t)row * DFF + c); gv[i] = *(const u32x4*)(GBF + (size_t)row * DFF + c); }
#pragma unroll
        for (int i = 0; i < 4; ++i) { const int row = rb + i;
            if (row < r1) {
                const bool samp = row >= T_PROMPT; const int t = samp ? ((row - T_PROMPT) & 31) : (row & 2047); const int L = samp ? 32 : 2048; const int bl = samp ? ((row - T_PROMPT) >> 5) : (row >> 11);
                if (t == 0) {
#pragma unroll
                    for (int e = 0; e < 8; ++e) { am1[e] = samp ? p.state_ffn[((size_t)bl * 2 + 1) * DFF + c + e] : 0.f; am2[e] = samp ? p.state_ffn[((size_t)bl * 2) * DFF + c + e] : 0.f; } }
                float ac[8], gf[8], res[8]; unpack8(av[i], ac); unpack8(gv[i], gf);
#pragma unroll
                for (int e = 0; e < 8; ++e) { res[e] = gelu_f(cb[e] + w0[e] * am2[e] + w1[e] * am1[e] + w2[e] * ac[e]) * gf[e]; am2[e] = am1[e]; am1[e] = ac[e]; }
                if (!dry) { u32x4 r; r.x = cvt_pk_bf16(res[0], res[1]); r.y = cvt_pk_bf16(res[2], res[3]); r.z = cvt_pk_bf16(res[4], res[5]); r.w = cvt_pk_bf16(res[6], res[7]);
                    *(u32x4*)(GBF + (size_t)row * DFF + c) = r;
                    if (t >= L - 2) { float* so = p.out + (samp ? OUT_FFNS : OUT_FFNP) + ((size_t)bl * 2 + (t - (L - 2))) * DFF + c;
                        *(f32x4*)so = (f32x4){ac[0], ac[1], ac[2], ac[3]}; *(f32x4*)(so + 4) = (f32x4){ac[4], ac[5], ac[6], ac[7]}; } }
            } }
    }
}

__device__ __forceinline__ void phase_ln2(const Params& p, const bool dry) {
    const int tid = threadIdx.x, wave = tid >> 6, lane = tid & 63;
    for (int rowb = (blockIdx.x * 8 + wave) * 4; rowb < T_ALL; rowb += gridDim.x * 32) {
        f32x4 v[4][4]; float rstd[4];
#pragma unroll
        for (int rr = 0; rr < 4; ++rr)
#pragma unroll
            for (int j = 0; j < 4; ++j) {
                if (rowb < T_PROMPT) v[rr][j] = ((const f32x4*)(p.out + (size_t)(rowb + rr) * 1024))[lane + 64 * j];
                else { const float* zs = (const float*)(p.ws + OFF_AU) + (size_t)(rowb + rr - T_PROMPT) * 1024; f32x4 a = ((const f32x4*)zs)[lane + 64 * j];
#pragma unroll
                    for (int k = 1; k < 11; ++k) a += ((const f32x4*)(zs + (size_t)k * 512 * 1024))[lane + 64 * j];
                    v[rr][j] = a; } }
#pragma unroll
        for (int rr = 0; rr < 4; ++rr) { float sm = 0.f;
#pragma unroll
            for (int j = 0; j < 4; ++j) sm += (v[rr][j][0] + v[rr][j][1]) + (v[rr][j][2] + v[rr][j][3]);
            const float mean = wave_sum(sm) * (1.0f / 1024.0f); float s2 = 0.f;
#pragma unroll
            for (int j = 0; j < 4; ++j) { v[rr][j] = v[rr][j] - mean; s2 += (v[rr][j][0] * v[rr][j][0] + v[rr][j][1] * v[rr][j][1]) + (v[rr][j][2] * v[rr][j][2] + v[rr][j][3] * v[rr][j][3]); }
            rstd[rr] = 1.0f / sqrtf(wave_sum(s2) * (1.0f / 1024.0f) + LN_EPS); }
#pragma unroll
        for (int j = 0; j < 4; ++j) { const int c = 4 * (lane + 64 * j);
            const f32x4 gv = *(const f32x4*)(p.ln2_g + c), bv = *(const f32x4*)(p.ln2_b + c);
#pragma unroll
            for (int rr = 0; rr < 4; ++rr) if (!dry) ((f32x4*)(p.out + (size_t)(rowb + rr) * 1024))[lane + 64 * j] = v[rr][j] * rstd[rr] * gv + bv; }
    }
}

#define XB_TMO      128
#define XB_XCNT(j)  (256  + 64 * (j))
#define XB_XSUB(j)  (1280 + 64 * (j))
#define XB_XGEN(j)  (2304 + 64 * (j))
#define XB_TOP      3328
#define XB_TOPGEN   3392
#define XCD_BAR_WORDS 3456
#define XB_SPIN_CAP (1u << 22)
__device__ __forceinline__ unsigned xb_ld(unsigned* p)              { return __hip_atomic_load(p, __ATOMIC_RELAXED, __HIP_MEMORY_SCOPE_AGENT); }
__device__ __forceinline__ unsigned xb_add(unsigned* p, unsigned v) { return __hip_atomic_fetch_add(p, v, __ATOMIC_RELAXED, __HIP_MEMORY_SCOPE_AGENT); }
__device__ __forceinline__ unsigned xb_xcc_id() { return (unsigned)__builtin_amdgcn_s_getreg((3 << 11) | 20) & 0xFu; }
#define XB_SPIN(cond, bar) do { unsigned _sp = 0; while (cond) { __builtin_amdgcn_s_sleep(1); \
    if ((++_sp & 255u) == 0u) { if (xb_ld(&(bar)[XB_TMO])) break; if (_sp > XB_SPIN_CAP) { atomicAdd(&(bar)[XB_TMO], 1u); break; } } } } while (0)
struct XcdBarrier { unsigned* bar; unsigned x; volatile LAS unsigned* st; };
__device__ __forceinline__ XcdBarrier xcd_barrier_post(unsigned* bar, volatile LAS unsigned* st) {
    XcdBarrier b; b.bar = bar; b.x = xb_xcc_id(); b.st = st;
    if (threadIdx.x == 0) (void)xb_add(&bar[XB_XCNT(b.x)], 1u);
    return b;
}
__device__ __forceinline__ void xcd_barrier_complete(unsigned* bar, unsigned x, unsigned& nloc, unsigned& nx) {
    const unsigned G = gridDim.x * gridDim.y * gridDim.z;
    unsigned sum, cnt, mine, sp = 0u;
    for (;;) {
        sum = 0u; cnt = 0u; mine = 0u;
#pragma unroll
        for (unsigned j = 0; j < 16; ++j) { const unsigned c = xb_ld(&bar[XB_XCNT(j)]); sum += c; cnt += (c > 0u) ? 1u : 0u; mine = (j == x) ? c : mine; }
        if (sum == G) break;
        __builtin_amdgcn_s_sleep(1);
        if ((++sp & 255u) == 0u) { if (xb_ld(&bar[XB_TMO])) break; if (sp > XB_SPIN_CAP) { atomicAdd(&bar[XB_TMO], 1u); break; } }
    }
    nloc = mine > 0u ? mine : 1u; nx = cnt > 0u ? cnt : 1u;
}
__device__ __forceinline__ void xcd_barrier(const XcdBarrier& b) {
    asm volatile("s_waitcnt vmcnt(0)" ::: "memory");
    __syncthreads();
    if (threadIdx.x == 0) {
        unsigned* bar = b.bar;
        __builtin_amdgcn_s_waitcnt(0);
        unsigned nloc = b.st[0], nx = b.st[1];
        if (nloc == 0u) { xcd_barrier_complete(bar, b.x, nloc, nx); b.st[0] = nloc; b.st[1] = nx; }
        const unsigned old = xb_add(&bar[XB_XSUB(b.x)], 1u);
        const unsigned gen = old / nloc;
        if (old + 1u == (gen + 1u) * nloc) {
            __builtin_amdgcn_fence(__ATOMIC_RELEASE, "agent");
            asm volatile("s_waitcnt vmcnt(0)" ::: "memory");
            const unsigned og = xb_add(&bar[XB_TOP], 1u);
            const unsigned tg = og / nx;
            if (og + 1u == (tg + 1u) * nx) xb_add(&bar[XB_TOPGEN], 1u);
            else XB_SPIN(xb_ld(&bar[XB_TOPGEN]) == tg, bar);
            __builtin_amdgcn_fence(__ATOMIC_ACQUIRE, "agent");
            xb_add(&bar[XB_XGEN(b.x)], 1u);
            asm volatile("s_waitcnt vmcnt(0)" ::: "memory");
        } else {
            XB_SPIN(xb_ld(&bar[XB_XGEN(b.x)]) == gen, bar);
            __builtin_amdgcn_fence(__ATOMIC_ACQUIRE, "agent");
            asm volatile("s_waitcnt vmcnt(0)" ::: "memory");
        }
    }
    __syncthreads();
}

constexpr int NPHASES = 14;
#ifndef REP_MASK
#define REP_MASK 0
#endif
#ifndef PH_MASK
#define PH_MASK 0xFFFF
#endif
#define PH_ON(k) ((PH_MASK >> (k)) & 1)
__global__ void __launch_bounds__(512, 2) mega_fwd(Params p) {
    extern __shared__ __attribute__((aligned(16))) unsigned char shm[];
    LAS unsigned char* lds = (LAS unsigned char*)shm;
    cg::grid_group grid = cg::this_grid();
    unsigned char* ws = p.ws;
    if (threadIdx.x < 4) ((LAS unsigned*)(lds + LDS_BAR_OFF))[threadIdx.x] = 0u;
    __syncthreads();
    const XcdBarrier xbar = xcd_barrier_post((unsigned*)(ws + OFF_BAR), (volatile LAS unsigned*)(lds + LDS_BAR_OFF));
    const int G = gridDim.x, c = blockIdx.x;
    const int lo = p.ph_lo, hi = p.ph_hi;
#define PH_SYNC(k) do { if ((k) + 1 < hi) { if (lo > 1000) grid.sync(); else xcd_barrier(xbar); } } while (0)
    if (lo <= 0 && 0 < hi) { if constexpr (PH_ON(0)) { for (int rep = (p.rep_mask >> 0) & 1; rep >= 0; --rep) phase0(p, lds); } PH_SYNC(0); }
    if (lo <= 1 && 1 < hi) { if constexpr (PH_ON(1)) { for (int rep = (p.rep_mask >> 1) & 1; rep >= 0; --rep) phase1(p, lds); } PH_SYNC(1); }
    if (lo <= 2 && 2 < hi) { if constexpr (PH_ON(2)) { { pg8::Gemm g{(const bf16_t*)p.out, (const bf16_t*)(ws + OFF_WIN), T_ALL, 17 * 256, 1024, 1024}; pg8::StaticOrder S; S.init(g.M, g.N, G, c, g.K);
            EpiIn<0> E{(bf16_t*)(ws + OFF_Q), (bf16_t*)(ws + OFF_K), (bf16_t*)(ws + OFF_ACAT), nullptr, nullptr, nullptr, nullptr, (const float*)(ws + OFF_ROT)};
            S.total = S.nwg << ((p.rep_mask >> 2) & 1); pg8::gemm_phase(lds, g, S, E); } } PH_SYNC(2); }
    if (lo <= 3 && 3 < hi) { if constexpr (PH_ON(3)) { for (int rep = (p.rep_mask >> 3) & 1; rep >= 0; --rep) phase_retention(p, lds, rep > 0); } PH_SYNC(3); }
    if (lo <= 4 && 4 < hi) { if constexpr (PH_ON(4)) { { pg8::Gemm g{(const bf16_t*)p.out, (const bf16_t*)(ws + OFF_WIN) + (size_t)17 * 256 * 1024, T_ALL, 19 * 256, 1024, 1024}; pg8::StaticOrder S; S.init(g.M, g.N, G, c, g.K);
            EpiIn<1> E{nullptr, nullptr, (bf16_t*)(ws + OFF_ACAT), (bf16_t*)(ws + OFF_G), (bf16_t*)(ws + OFF_U), (bf16_t*)(ws + OFF_RS_S), (bf16_t*)(ws + OFF_RS_S) + 512 * 1024, nullptr};
            S.add_extra(128, 2, 19, 8); pg8::gemm_phase(lds, g, S, E); } } PH_SYNC(4); }
    if (lo <= 5 && 5 < hi) { if constexpr (PH_ON(5)) { for (int rep = (p.rep_mask >> 5) & 1; rep >= 0; --rep) phase_mix_elem(p, rep > 0); } PH_SYNC(5); }
    if (lo <= 6 && 6 < hi) { if constexpr (PH_ON(6)) { { pg8::Gemm g{(const bf16_t*)p.out, (const bf16_t*)(ws + OFF_WIN) + (size_t)36 * 256 * 1024, T_PROMPT, 8 * 256, 1024, 1024}; pg8::StaticOrder S; S.init(g.M, g.N, G, c, g.K);
            EpiIn<2> E{nullptr, nullptr, nullptr, nullptr, nullptr, (bf16_t*)(ws + OFF_R), (bf16_t*)(ws + OFF_SC), nullptr};
            S.total = S.nwg << ((p.rep_mask >> 6) & 1); pg8::gemm_phase(lds, g, S, E); } } PH_SYNC(6); }
    if (lo <= 7 && 7 < hi) { if constexpr (PH_ON(7)) { { pg8::Gemm g{(const bf16_t*)(ws + OFF_ACAT), (const bf16_t*)(ws + OFF_WCAT), T_ALL, 1024, 3072, 3072}; pg8::StaticOrder S; S.init(g.M, g.N, G, c, g.K);
            EpiMerged E{(const bf16_t*)(ws + OFF_R), (const bf16_t*)(ws + OFF_SC), (bf16_t*)(ws + OFF_MERGED), (float*)(ws + OFF_MS32), (const bf16_t*)(ws + OFF_RS_S), (const bf16_t*)(ws + OFF_RS_S) + 512 * 1024};
            S.split_tail(2, 4); pg8::gemm_phase(lds, g, S, E); }
            xcd_barrier(xbar);
            { const float* ms = (const float*)(ws + OFF_MS32); bf16_t* mo = (bf16_t*)(ws + OFF_MERGED) + (size_t)T_PROMPT * 1024;
              for (int i = blockIdx.x * 512 + threadIdx.x; i < 512 * 1024 / 4; i += gridDim.x * 512) { f32x4 v = ((const f32x4*)ms)[i];
#pragma unroll
                  for (int k = 1; k < 12; ++k) v += ((const f32x4*)(ms + (size_t)k * 512 * 1024))[i];
                  u32x2 w; w.x = cvt_pk_bf16(v[0], v[1]); w.y = cvt_pk_bf16(v[2], v[3]); ((u32x2*)mo)[i] = w; } } } PH_SYNC(7); }
    if (lo <= 8 && 8 < hi) { if constexpr (PH_ON(8)) { { pg8::Gemm g{(const bf16_t*)(ws + OFF_MERGED), (const bf16_t*)(ws + OFF_WOUT), T_ALL, 1024, 1024, 1024}; pg8::StaticOrder S; S.init(g.M, g.N, G, c, g.K);
            EpiOut E{p.x_prompt, p.x_sample, (const float*)(ws + OFF_LNST), p.ln_in_g, p.ln_in_b, p.b_out, (const float*)(ws + OFF_MOD), p.out, (float*)(ws + OFF_MS32)};
            S.split_tail(2, 4); pg8::gemm_phase(lds, g, S, E); } } PH_SYNC(8); }
    if (lo <= 9 && 9 < hi) { if constexpr (PH_ON(9)) { for (int rep = (p.rep_mask >> 9) & 1; rep >= 0; --rep) phase_ln1(p, rep > 0); } PH_SYNC(9); }
    if (lo <= 10 && 10 < hi) { if constexpr (PH_ON(10)) { { pg8::Gemm g{(const bf16_t*)p.out, (const bf16_t*)(ws + OFF_WUP), T_ALL, 5632, 1024, 2048}; pg8::StaticOrder S; S.init(g.M, g.N, G, c, g.K);
            EpiUp E{(bf16_t*)(ws + OFF_AU), (bf16_t*)(ws + OFF_GBF)};
            S.total = S.nwg << ((p.rep_mask >> 10) & 1); pg8::gemm_phase(lds, g, S, E); } } PH_SYNC(10); }
    if (lo <= 11 && 11 < hi) { if constexpr (PH_ON(11)) { for (int rep = (p.rep_mask >> 11) & 1; rep >= 0; --rep) phase_ffn_elem(p, rep > 0); } PH_SYNC(11); }
    if (lo <= 12 && 12 < hi) { if constexpr (PH_ON(12)) { { pg8::Gemm g{(const bf16_t*)(ws + OFF_GBF), (const bf16_t*)(ws + OFF_WDOWN), T_ALL, 1024, DFF, DFF}; pg8::StaticOrder S; S.init(g.M, g.N, G, c, g.K);
            EpiDown E{(const bf16_t*)(ws + OFF_X1), p.b_down, (const float*)(ws + OFF_MOD), p.out, (float*)(ws + OFF_AU)};
            S.split_tail(2, 4); pg8::gemm_phase(lds, g, S, E); } } PH_SYNC(12); }
    if (lo <= 13 && 13 < hi) { if constexpr (PH_ON(13)) { for (int rep = (p.rep_mask >> 13) & 1; rep >= 0; --rep) phase_ln2(p, rep > 0); } PH_SYNC(13); }
}

extern "C" void kernel_launch(void* const* d_in, const int* in_sizes, int n_in, void* d_out, int out_size, void* d_ws, size_t ws_size, hipStream_t stream) {
    static int grid = 0;
    if (grid == 0) {
        if (n_in != 27 || ws_size < WS_NEED) { fprintf(stderr, "kernel_launch: n_in %d ws %zu (need %zu)\n", n_in, ws_size, (size_t)WS_NEED); grid = -1; return; }
        int dev = 0, cus = 0, per_cu = 0;
        hipGetDevice(&dev); hipDeviceGetAttribute(&cus, hipDeviceAttributeMultiprocessorCount, dev);
        if (hipFuncSetAttribute((const void*)mega_fwd, hipFuncAttributeMaxDynamicSharedMemorySize, LDS_BYTES) != hipSuccess) { fprintf(stderr, "hipFuncSetAttribute failed\n"); grid = -1; return; }
        if (hipOccupancyMaxActiveBlocksPerMultiprocessor(&per_cu, (const void*)mega_fwd, 512, LDS_BYTES) != hipSuccess || per_cu < 1) { fprintf(stderr, "occupancy query: %d\n", per_cu); per_cu = 1; }
        (void)hipGetLastError();
        grid = cus * 1;
    }
    if (grid < 0) return;
    Params p{};
    const float** f = (const float**)&p;
    for (int i = 0; i < 27; ++i) f[i] = (const float*)d_in[i];
    p.out = (float*)d_out; p.ws = (unsigned char*)d_ws; p.ph_lo = 0; p.ph_hi = NPHASES; p.rep_mask = REP_MASK; p.pad = 0;
    if (hipMemsetAsync((char*)d_ws + OFF_BAR, 0, XCD_BAR_WORDS * 4, stream) != hipSuccess) { fprintf(stderr, "memset failed\n"); return; }
    void* args[] = {&p};
    hipError_t e = hipLaunchCooperativeKernel((const void*)mega_fwd, dim3(grid), dim3(512), args, LDS_BYTES, stream);
    if (e != hipSuccess) fprintf(stderr, "cooperative launch failed: %s (grid %d)\n", hipGetErrorString(e), grid);
}
```

```cpp
#include <hip/hip_runtime.h>
#include <hip/hip_cooperative_groups.h>
#include <cstdio>
#include <cstdint>
namespace cg = cooperative_groups;

#define LAS __attribute__((address_space(3)))
typedef unsigned short bf16_t;
typedef short bf16x8 __attribute__((ext_vector_type(8)));
typedef float f32x4 __attribute__((ext_vector_type(4)));
typedef float f32x2 __attribute__((ext_vector_type(2)));
typedef unsigned u32x4 __attribute__((ext_vector_type(4)));
typedef unsigned u32x2 __attribute__((ext_vector_type(2)));

constexpr int T_ALL = 33280, T_PROMPT = 32768, DM = 1024, DFF = 2816;
constexpr float LN_EPS = 1e-5f;
constexpr float ALPHA = 1.189207115002721f;
constexpr size_t S1 = (size_t)T_ALL * 1024 * 2;
constexpr size_t OFF_WIN = 0, OFF_WCAT = 23068672, OFF_WOUT = 29360128, OFF_WUP = 31457280, OFF_WDOWN = 42991616;
constexpr size_t OFF_MODP = 62914560  , OFF_MOD = 55050240, OFF_ROT = 55836672, OFF_LNST = 57966592, OFF_RST = 58232832;
constexpr size_t OFF_ACT = 62914560;
constexpr size_t OFF_ACAT = OFF_ACT, OFF_Q = OFF_ACT + 3 * S1, OFF_K = OFF_ACT + 4 * S1, OFF_G = OFF_ACT + 3 * S1, OFF_R = OFF_ACT + 3 * S1, OFF_SC = OFF_ACT + 4 * S1;
constexpr size_t OFF_U = OFF_ACT + 5 * S1, OFF_MERGED = OFF_ACT + 5 * S1, OFF_MS32 = OFF_ACT + 6 * S1, OFF_RS_S = OFF_MS32 + (size_t)12 * 512 * 1024 * 4;
constexpr size_t OFF_X1 = OFF_ACT, OFF_AU = OFF_ACT + S1, OFF_GBF = OFF_AU + (size_t)T_ALL * DFF * 2;
constexpr size_t WS_NEED = OFF_GBF + (size_t)T_ALL * DFF * 2;
constexpr size_t OUT_YS = 33554432, OUT_RETP = 34078720, OUT_CONVP = 42467328, OUT_FFNP = 42500096, OUT_RETS = 42590208, OUT_CONVS = 50978816, OUT_FFNS = 51011584;
constexpr int LDS_BAR_OFF = 136192, LDS_BYTES = 136192 + 16;
constexpr size_t OFF_BAR = 62492672;

struct Params {
    const float *x_prompt, *x_sample, *c_prompt, *c_sample, *state_ret, *state_conv, *state_ffn;
    const float *ln_in_g, *ln_in_b, *w_mod, *b_mod, *w_in, *w_o_ret, *conv_w, *conv_b, *w_o_conv, *w_out, *b_out;
    const float *ln1_g, *ln1_b, *w_up, *ffn_conv_w, *ffn_conv_b, *w_down, *b_down, *ln2_g, *ln2_b;
    float* out; unsigned char* ws; int ph_lo, ph_hi, rep_mask, pad;
};

__device__ __forceinline__ unsigned cvt_pk_bf16(float lo, float hi) { unsigned r; asm volatile("v_cvt_pk_bf16_f32 %0, %1, %2" : "=v"(r) : "v"(lo), "v"(hi)); return r; }
__device__ __forceinline__ float bf_lo(unsigned w) { return __uint_as_float(w << 16); }
__device__ __forceinline__ float bf_hi(unsigned w) { return __uint_as_float(w & 0xffff0000u); }
__device__ __forceinline__ float wave_sum(float v) {
#pragma unroll
    for (int o = 1; o < 64; o <<= 1) v += __shfl_xor(v, o);
    return v;
}
__device__ __forceinline__ int row_seq(int row) { return row < T_PROMPT ? (row >> 11) : 16 + ((row - T_PROMPT) >> 5); }
__device__ __forceinline__ int row_pos(int row) { return row < T_PROMPT ? (row & 2047) : 2048 + ((row - T_PROMPT) & 31); }
__device__ __forceinline__ float sigmoidf_(float x) { return 1.0f / (1.0f + __expf(-x)); }
__device__ __forceinline__ float gelu_f(float v) {
    const float av = fabsf(v), t = __builtin_amdgcn_rcpf(av * 0.2316418882f + 1.0f);
    float q = t * 0.5307027145f + (-0.7265760135f); q = q * t + 0.7107068705f; q = q * t + (-0.142248368f); q = q * t + 0.127414796f; q = q * t;
    const float e = __builtin_amdgcn_exp2f((v * v) * (-0.72134752044f));
    const float m = v * (q * e);
    return v < 0.f ? m : v - m;
}

namespace pg8 {
constexpr int BM = 256, BK = 64, HALF = 128, HTB = HALF * BK * 2, STAGE_BYTES = 8 * HTB, NXCD = 8, WGM = 4;
__host__ __device__ __forceinline__ int lds_byte(int r, int c) { const int st = (r >> 4) * 2 + (c >> 5), rr = r & 15, cc = c & 31, ob = rr * 64 + cc * 2; return st * 1024 + (ob ^ (((ob >> 9) & 1) << 5)); }
__host__ __device__ __forceinline__ void stage_rc(int b, int& R, int& C) { const int st = b / 1024, sb = b % 1024, swz = sb ^ (((sb >> 9) & 1) << 5); R = (st >> 1) * 16 + swz / 64; C = (st & 1) * 32 + (swz % 64) / 2; }
__host__ __device__ __forceinline__ int perm32(int rho) { const int n = rho >> 4, i = rho & 15; return 8 * (i >> 2) + 4 * n + (i & 3); }
struct Unit { int pm, pn, kt0, nkt; };
struct Gemm { const bf16_t* A; const bf16_t* Bt; int M, N, K, lda; };
struct StaticOrder {
    int nM, nN, nwg, G, c, total, ntf, nMs, npk, pkt, ex_pm0, ex_pn0, ex_nN;
    __device__ void init(int M, int N, int G_, int c_, int K) { nM = M / BM; nN = N / BM; nwg = nM * nN; G = G_; c = c_; total = nwg; ntf = K / BK; nMs = 0; npk = 1; pkt = ntf; ex_pm0 = 0; ex_pn0 = 0; ex_nN = 1; }
    __device__ void split_tail(int tail_tiles, int piece_kt) { nM -= tail_tiles; nMs = tail_tiles; nwg = nM * nN; pkt = piece_kt; npk = ntf / piece_kt; ex_pm0 = nM; ex_pn0 = 0; ex_nN = nN; total = nwg + nMs * nN * npk; }
    __device__ void add_extra(int pm0, int ntiles, int pn0, int nNe) { nMs = ntiles; ex_pm0 = pm0; ex_pn0 = pn0; ex_nN = nNe; npk = 1; pkt = ntf; total = nwg + ntiles * nNe; }
    __device__ bool next(int i, Unit& u) const {
        const long L = (long)i * G + c; if (L >= total) return false;
        if (nMs > 0 && L >= nwg) { const int sp = (int)L - nwg, un = sp / npk, kp = sp - un * npk; u.pm = ex_pm0 + un / ex_nN; u.pn = ex_pn0 + un % ex_nN; u.kt0 = kp * pkt; u.nkt = pkt; return true; }
        int wgid = (int)(L >= nwg ? L - nwg : L); { const int q = nwg / NXCD, r = nwg % NXCD, xcd = wgid % NXCD, off = wgid / NXCD; wgid = (xcd < r ? xcd * (q + 1) : r * (q + 1) + (xcd - r) * q) + off; }
        const int nig = WGM * nN, gid = wgid / nig, fm = gid * WGM, gsz = (nM - fm) < WGM ? (nM - fm) : WGM;
        u.pm = fm + ((wgid % nig) % gsz); u.pn = (wgid % nig) / gsz; u.kt0 = 0; u.nkt = ntf; return true;
    }
};
template <class Epi>
__device__ __forceinline__ void gemm_phase(LAS unsigned char* lds, const Gemm g, const StaticOrder& S, const Epi& E) {
    const int tid = threadIdx.x, wid = __builtin_amdgcn_readfirstlane(tid >> 6), lane = tid & 63, wr = wid >> 2, wc = wid & 3, fr = lane & 15, fq = lane >> 4;
    const int K = g.K, ntf = K / BK;
    unsigned voffA[2], voffB[2];
#pragma unroll
    for (int i = 0; i < 2; ++i) { int R, C; stage_rc(tid * 16 + i * 8192, R, C); const int Rb = Epi::PERM ? ((R & ~31) + perm32(R & 31)) : R;
        voffA[i] = (unsigned)(R * g.lda + C) * 2u; voffB[i] = (unsigned)(Rb * K + C) * 2u; }
    const size_t kstep = (size_t)(BK * 2);
    const size_t hstepA = (size_t)HALF * g.lda * 2, hstepB = (size_t)HALF * K * 2;
    const size_t tstepA = 2 * hstepA, tstepB = 2 * hstepB;
    const unsigned ldsw = (unsigned)wid * 1024u;
    const int aoff = lds_byte(wr * 64 + fr, fq * 8), boff = lds_byte(wc * 32 + fr, fq * 8);
#define PG8_SA(b, h) (((b) * 2 + (h)) * HTB)
#define PG8_SB(b, h) ((4 + (b) * 2 + (h)) * HTB)
#define PG8_STAGE(bufoff, gbase, voff) do { _Pragma("unroll") for (int _i = 0; _i < 2; ++_i) \
        __builtin_amdgcn_global_load_lds((const unsigned*)((const char*)(gbase) + (voff)[_i]), (LAS unsigned*)(lds + (bufoff) + ldsw + _i * 8192), 16, 0, 0); } while (0)
#define PG8_LDA(dst, b, h) do { _Pragma("unroll") for (int m = 0; m < 4; ++m) _Pragma("unroll") for (int k = 0; k < 2; ++k) dst[m][k] = *(const LAS bf16x8*)(lds + PG8_SA(b, h) + aoff + m * 2048 + k * 1024); } while (0)
#define PG8_LDB(dst, b, h) do { _Pragma("unroll") for (int n = 0; n < 2; ++n) _Pragma("unroll") for (int k = 0; k < 2; ++k) dst[n][k] = *(const LAS bf16x8*)(lds + PG8_SB(b, h) + boff + n * 2048 + k * 1024); } while (0)
#define PG8_MMA(ai, bj, At, Bt) do { __builtin_amdgcn_s_setprio(1); _Pragma("unroll") for (int m = 0; m < 4; ++m) _Pragma("unroll") for (int n = 0; n < 2; ++n) _Pragma("unroll") for (int k = 0; k < 2; ++k) \
        acc[ai][bj][m][n] = __builtin_amdgcn_mfma_f32_16x16x32_bf16(Bt[n][k], At[m][k], acc[ai][bj][m][n], 0, 0, 0); __builtin_amdgcn_s_setprio(0); } while (0)
#define PG8_WAIT_V(n) asm volatile("s_waitcnt vmcnt(" #n ")" ::: "memory")
#define PG8_WAIT_L(n) asm volatile("s_waitcnt lgkmcnt(" #n ")" ::: "memory")
#define PG8_BAR __builtin_amdgcn_s_barrier()
#define PG8_SCHED __builtin_amdgcn_sched_barrier(0)
    Unit cur, nxt; int ui = 0;
    if (!S.next(0, cur)) return;
    f32x4 acc[2][2][4][2];
#pragma unroll
    for (int a = 0; a < 2; ++a)
#pragma unroll
        for (int b = 0; b < 2; ++b)
#pragma unroll
            for (int m = 0; m < 4; ++m)
#pragma unroll
                for (int n = 0; n < 2; ++n) acc[a][b][m][n] = (f32x4){0.f, 0.f, 0.f, 0.f};
    bf16x8 At[4][2], B0[2][2], B1[2][2];
    const char* cA = (const char*)g.A + (size_t)cur.pm * tstepA + (size_t)cur.kt0 * kstep; const char* cB = (const char*)g.Bt + (size_t)cur.pn * tstepB + (size_t)cur.kt0 * kstep;
    PG8_STAGE(PG8_SB(0, 0), cB, voffB); PG8_STAGE(PG8_SB(0, 1), cB + hstepB, voffB); PG8_STAGE(PG8_SA(0, 0), cA, voffA); PG8_STAGE(PG8_SA(0, 1), cA + hstepA, voffA);
    if (wr == 1) PG8_BAR;
    PG8_WAIT_V(2); PG8_BAR;
    PG8_STAGE(PG8_SB(1, 0), cB + kstep, voffB); PG8_STAGE(PG8_SA(1, 0), cA + kstep, voffA); PG8_STAGE(PG8_SB(1, 1), cB + hstepB + kstep, voffB);
    PG8_WAIT_V(6); PG8_BAR;
    for (;;) {
        const bool has_next = S.next(ui + 1, nxt);
        const char* nA = has_next ? (const char*)g.A + (size_t)nxt.pm * tstepA + (size_t)nxt.kt0 * kstep : cA; const char* nB = has_next ? (const char*)g.Bt + (size_t)nxt.pn * tstepB + (size_t)nxt.kt0 * kstep : cB;
        const int nt = cur.nkt;
        for (int t = 0; t < nt; t += 2) {
            const bool last = (t == nt - 2);
            const char* a1 = cA + (size_t)(t + 1) * kstep;
            const char* a2 = last ? nA : cA + (size_t)(t + 2) * kstep; const char* b2 = last ? nB : cB + (size_t)(t + 2) * kstep;
            const char* a3 = a2 + kstep; const char* b3 = b2 + kstep;
            if constexpr (Epi::HOOK_T > 0) { if (t == Epi::HOOK_T && nt == ntf) { E.mid(acc, cur, wr, wc, fr, fq); PG8_SCHED; } }
            PG8_LDB(B0, 0, 0); PG8_LDB(B1, 0, 1); PG8_SCHED; PG8_LDA(At, 0, 0); PG8_STAGE(PG8_SA(1, 1), a1 + hstepA, voffA);
            PG8_WAIT_V(8); PG8_WAIT_L(0); PG8_BAR; PG8_MMA(0, 0, At, B0); PG8_MMA(0, 1, At, B1); PG8_BAR; PG8_SCHED;
            PG8_LDA(At, 0, 1); PG8_STAGE(PG8_SB(0, 0), b2, voffB); PG8_STAGE(PG8_SB(0, 1), b2 + hstepB, voffB); PG8_STAGE(PG8_SA(0, 0), a2, voffA);
            PG8_WAIT_V(8); PG8_WAIT_L(0); PG8_BAR; PG8_MMA(1, 0, At, B0); PG8_MMA(1, 1, At, B1); PG8_BAR; PG8_SCHED;
            PG8_LDB(B0, 1, 0); PG8_LDB(B1, 1, 1); PG8_SCHED; PG8_LDA(At, 1, 0); PG8_STAGE(PG8_SA(0, 1), a2 + hstepA, voffA);
            PG8_WAIT_V(8); PG8_WAIT_L(0); PG8_BAR; PG8_MMA(0, 0, At, B0); PG8_MMA(0, 1, At, B1); PG8_BAR; PG8_SCHED;
            PG8_LDA(At, 1, 1); PG8_STAGE(PG8_SB(1, 0), b3, voffB); PG8_STAGE(PG8_SB(1, 1), b3 + hstepB, voffB); PG8_STAGE(PG8_SA(1, 0), a3, voffA);
            PG8_WAIT_V(8); PG8_WAIT_L(0); PG8_BAR; PG8_MMA(1, 0, At, B0); PG8_MMA(1, 1, At, B1); PG8_BAR; PG8_SCHED;
        }
        if (wr == 0) PG8_BAR;
        E(acc, cur, wr, wc, fr, fq);
        if (!has_next) break;
#pragma unroll
        for (int a = 0; a < 2; ++a)
#pragma unroll
            for (int b = 0; b < 2; ++b)
#pragma unroll
                for (int m = 0; m < 4; ++m)
#pragma unroll
                    for (int n = 0; n < 2; ++n) acc[a][b][m][n] = (f32x4){0.f, 0.f, 0.f, 0.f};
        cur = nxt; cA = nA; cB = nB; ++ui;
        if (wr == 1) PG8_BAR;
    }
    PG8_WAIT_V(0);
    PG8_BAR;
#undef PG8_SA
#undef PG8_SB
#undef PG8_STAGE
#undef PG8_LDA
#undef PG8_LDB
#undef PG8_MMA
#undef PG8_WAIT_V
#undef PG8_WAIT_L
#undef PG8_BAR
#undef PG8_SCHED
}
}
using pg8::Unit;

__device__ __forceinline__ void store8(bf16_t* p, const f32x4 v0, const f32x4 v1) {
    u32x4 w; w.x = cvt_pk_bf16(v0[0], v0[1]); w.y = cvt_pk_bf16(v0[2], v0[3]); w.z = cvt_pk_bf16(v1[0], v1[1]); w.w = cvt_pk_bf16(v1[2], v1[3]);
    *(u32x4*)p = w;
}
__device__ __forceinline__ void rs_store(const f32x4 (&acc)[2][2][4][2], int row0, int col, bf16_t* R, bf16_t* SC) {
#pragma unroll
    for (int ai = 0; ai < 2; ++ai)
#pragma unroll
        for (int m = 0; m < 4; ++m) { const int row = row0 + ai * 128 + m * 16;
            f32x4 r[2], s[2];
#pragma unroll
            for (int n = 0; n < 2; ++n)
#pragma unroll
                for (int j = 0; j < 4; ++j) { const float ea = __builtin_amdgcn_exp2f(acc[ai][0][m][n][j] * -1.4426950408889634f), eb = __builtin_amdgcn_exp2f(acc[ai][1][m][n][j] * -1.4426950408889634f);
                    s[n][j] = __builtin_amdgcn_rcpf(1.0f + eb); r[n][j] = (1.0f + eb) * __builtin_amdgcn_rcpf(1.0f + ea); }
            store8(R + (size_t)row * 1024 + col, r[0], r[1]); store8(SC + (size_t)row * 1024 + col, s[0], s[1]); }
}
template <int SUB> struct EpiIn {
    static constexpr bool PERM = true; static constexpr int HOOK_T = -1;
    bf16_t *Q, *Kb, *ACAT, *G, *U, *R, *SC; const float* rot;
    __device__ __forceinline__ void mid(f32x4 (&)[2][2][4][2], const Unit&, int, int, int, int) const {}
    __device__ __forceinline__ void operator()(const f32x4 (&acc)[2][2][4][2], const Unit& u, int wr, int wc, int fr, int fq) const {
        asm volatile("" : "+v"(fr), "+v"(fq));
        const int row0 = u.pm * 256 + wr * 64 + fr; const int cl = wc * 32 + 8 * fq;
        if constexpr (SUB == 0) {
            if (u.pn < 8) {
                bf16_t* base = (u.pn < 4) ? Q : Kb; const float sc = (u.pn < 4) ? 1.0f : 0.0625f; const int colt = (u.pn & 3) * 256;
#pragma unroll
                for (int ai = 0; ai < 2; ++ai)
#pragma unroll
                    for (int m = 0; m < 4; ++m) { const int row = row0 + ai * 128 + m * 16; const int pos = row_pos(row);
#pragma unroll
                        for (int bj = 0; bj < 2; ++bj) { const int c0 = bj * 128 + cl;
                            const f32x4* rp = (const f32x4*)(rot + ((size_t)pos * 128 + (c0 >> 1)) * 2);
                            const f32x4 t0 = rp[0], t1 = rp[1];
                            const f32x4 a = acc[ai][bj][m][0], b = acc[ai][bj][m][1];
                            f32x4 o0, o1;
                            o0[0] = (a[0] * t0[0] - a[1] * t0[1]) * sc; o0[1] = (a[0] * t0[1] + a[1] * t0[0]) * sc;
                            o0[2] = (a[2] * t0[2] - a[3] * t0[3]) * sc; o0[3] = (a[2] * t0[3] + a[3] * t0[2]) * sc;
                            o1[0] = (b[0] * t1[0] - b[1] * t1[1]) * sc; o1[1] = (b[0] * t1[1] + b[1] * t1[0]) * sc;
                            o1[2] = (b[2] * t1[2] - b[3] * t1[3]) * sc; o1[3] = (b[2] * t1[3] + b[3] * t1[2]) * sc;
                            store8(base + (size_t)row * 1024 + colt + c0, o0, o1); } }
            } else {
                const int colt = (u.pn - 8) * 256;
#pragma unroll
                for (int ai = 0; ai < 2; ++ai)
#pragma unroll
                    for (int m = 0; m < 4; ++m) { const int row = row0 + ai * 128 + m * 16;
#pragma unroll
                        for (int bj = 0; bj < 2; ++bj) store8(ACAT + (size_t)row * 3072 + colt + bj * 128 + cl, acc[ai][bj][m][0], acc[ai][bj][m][1]); }
            }
        } else if constexpr (SUB == 1) {
            if (u.pn >= 19) {
                rs_store(acc, row0 - T_PROMPT, (u.pn - 19) * 128 + cl, R, SC);
            } else if (u.pn < 11) {
                bf16_t* base; int ld;
                if (u.pn < 8) { base = G + u.pn * 256; ld = 2048; } else { base = ACAT + 2048 + (u.pn - 7) * 256; ld = 3072; }
#pragma unroll
                for (int ai = 0; ai < 2; ++ai)
#pragma unroll
                    for (int m = 0; m < 4; ++m) { const int row = row0 + ai * 128 + m * 16;
#pragma unroll
                        for (int bj = 0; bj < 2; ++bj) store8(base + (size_t)row * ld + bj * 128 + cl, acc[ai][bj][m][0], acc[ai][bj][m][1]); }
            } else {
                const int colt = (u.pn - 11) * 128;
#pragma unroll
                for (int ai = 0; ai < 2; ++ai)
#pragma unroll
                    for (int m = 0; m < 4; ++m) { const int row = row0 + ai * 128 + m * 16;
                        store8(U + (size_t)row * 1024 + colt + cl, acc[ai][0][m][0] * acc[ai][1][m][0], acc[ai][0][m][1] * acc[ai][1][m][1]); }
            }
        } else {
            rs_store(acc, row0, u.pn * 128 + cl, R, SC);
        }
    }
};
struct EpiMerged {
    static constexpr bool PERM = true; static constexpr int HOOK_T = 32;
    const bf16_t *R, *SC; bf16_t* O; float* MS32; const bf16_t *Rs, *SCs;
    __device__ __forceinline__ void mid(f32x4 (&acc)[2][2][4][2], const Unit& u, int wr, int wc, int fr, int fq) const {
        asm volatile("" : "+v"(fr), "+v"(fq));
        const int row0 = u.pm * 256 + wr * 64 + fr, col0 = u.pn * 256 + wc * 32 + 8 * fq;
#pragma unroll
        for (int ai = 0; ai < 2; ++ai)
#pragma unroll
            for (int m = 0; m < 4; ++m) { const int row = row0 + ai * 128 + m * 16;
#pragma unroll
                for (int bj = 0; bj < 2; ++bj) { const u32x4 w = *(const u32x4*)(R + (size_t)row * 1024 + col0 + bj * 128);
                    acc[ai][bj][m][0] *= (f32x4){bf_lo(w.x), bf_hi(w.x), bf_lo(w.y), bf_hi(w.y)}; acc[ai][bj][m][1] *= (f32x4){bf_lo(w.z), bf_hi(w.z), bf_lo(w.w), bf_hi(w.w)}; }
                asm volatile("" ::: "memory"); }
    }
    __device__ __forceinline__ void operator()(const f32x4 (&acc)[2][2][4][2], const Unit& u, int wr, int wc, int fr, int fq) const {
        asm volatile("" : "+v"(fr), "+v"(fq));
        const int row0 = u.pm * 256 + wr * 64 + fr, col0 = u.pn * 256 + wc * 32 + 8 * fq;
        if (u.nkt != 48) {
            const bool ret = u.kt0 < 32;
#pragma unroll
            for (int ai = 0; ai < 2; ++ai)
#pragma unroll
                for (int m = 0; m < 4; ++m) { const int row = row0 + ai * 128 + m * 16;
#pragma unroll
                    for (int bj = 0; bj < 2; ++bj) { const u32x4 w = *(const u32x4*)(SCs + (size_t)(row - T_PROMPT) * 1024 + col0 + bj * 128);
                        u32x4 rw = (u32x4){0x3f803f80u, 0x3f803f80u, 0x3f803f80u, 0x3f803f80u};
                        if (ret) rw = *(const u32x4*)(Rs + (size_t)(row - T_PROMPT) * 1024 + col0 + bj * 128);
                        float* dst = MS32 + (size_t)(u.kt0 >> 2) * (512 * 1024) + (size_t)(row - T_PROMPT) * 1024 + col0 + bj * 128;
                        const f32x4 g0 = (f32x4){bf_lo(w.x) * bf_lo(rw.x), bf_hi(w.x) * bf_hi(rw.x), bf_lo(w.y) * bf_lo(rw.y), bf_hi(w.y) * bf_hi(rw.y)};
                        const f32x4 g1 = (f32x4){bf_lo(w.z) * bf_lo(rw.z), bf_hi(w.z) * bf_hi(rw.z), bf_lo(w.w) * bf_lo(rw.w), bf_hi(w.w) * bf_hi(rw.w)};
                        *(f32x4*)dst = acc[ai][bj][m][0] * g0; *(f32x4*)(dst + 4) = acc[ai][bj][m][1] * g1; }
                    asm volatile("" ::: "memory"); }
            return;
        }
#pragma unroll
        for (int ai = 0; ai < 2; ++ai)
#pragma unroll
            for (int m = 0; m < 4; ++m) { const int row = row0 + ai * 128 + m * 16;
#pragma unroll
                for (int bj = 0; bj < 2; ++bj) { const u32x4 w = *(const u32x4*)(SC + (size_t)row * 1024 + col0 + bj * 128);
                    store8(O + (size_t)row * 1024 + col0 + bj * 128, acc[ai][bj][m][0] * (f32x4){bf_lo(w.x), bf_hi(w.x), bf_lo(w.y), bf_hi(w.y)},
                           acc[ai][bj][m][1] * (f32x4){bf_lo(w.z), bf_hi(w.z), bf_lo(w.w), bf_hi(w.w)}); }
                asm volatile("" ::: "memory"); }
    }
};
struct EpiOut {
    static constexpr bool PERM = false; static constexpr int HOOK_T = -1;
    const float *x_prompt, *x_sample, *lnst, *ln_g, *ln_b, *bias, *mod; float* Z; float* ZS;
    __device__ __forceinline__ void mid(f32x4 (&)[2][2][4][2], const Unit&, int, int, int, int) const {}
    __device__ __forceinline__ void operator()(const f32x4 (&acc)[2][2][4][2], const Unit& u, int wr, int wc, int fr, int fq) const {
        asm volatile("" : "+v"(fr), "+v"(fq));
        const int row0 = u.pm * 256 + wr * 64 + fr, col0 = u.pn * 256 + wc * 32 + 4 * fq;
#pragma unroll
        for (int ai = 0; ai < 2; ++ai)
#pragma unroll
            for (int m = 0; m < 4; ++m) { const int row = row0 + ai * 128 + m * 16; const int s = row_seq(row);
                const float* xr = row < T_PROMPT ? x_prompt + (size_t)row * 1024 : x_sample + (size_t)(row - T_PROMPT) * 1024;
                const float mu = lnst[2 * row], rstd = lnst[2 * row + 1];
                const float* gt = mod + (size_t)s * 6144 + 2048;
#pragma unroll
                for (int bj = 0; bj < 2; ++bj)
#pragma unroll
                    for (int n = 0; n < 2; ++n) { const int c = col0 + bj * 128 + n * 16;
                        const f32x4 xv = *(const f32x4*)(xr + c), gv = *(const f32x4*)(ln_g + c), bv = *(const f32x4*)(ln_b + c), bo = *(const f32x4*)(bias + c), gg = *(const f32x4*)(gt + c);
                        const f32x4 xl = (xv - mu) * rstd * gv + bv;
                        if (u.nkt != 16) { f32x4 v = gg * acc[ai][bj][m][n]; if (u.kt0 == 0) v += xl * ALPHA + gg * bo;
                            *(f32x4*)(ZS + (size_t)(u.kt0 >> 2) * (512 * 1024) + (size_t)(row - T_PROMPT) * 1024 + c) = v; }
                        else *(f32x4*)(Z + (size_t)row * 1024 + c) = xl * ALPHA + gg * (acc[ai][bj][m][n] + bo); }
                asm volatile("" ::: "memory"); }
    }
};
__device__ __forceinline__ float* up_slab(float* ybase, int kp, int r, int pn) { const int sidx = (kp * 512 + r) * 22 + pn; return (float*)((char*)ybase + (size_t)(sidx >> 1) * 4096 + 2048 + (sidx & 1) * 1024); }
__device__ __forceinline__ u32x4 up_slab_sum8(const float* ybase, int r, int pn, int col) {
    f32x4 a = (f32x4){0.f, 0.f, 0.f, 0.f}, b = a;
#pragma unroll
    for (int kp = 0; kp < 4; ++kp) { const float* sp = up_slab((float*)ybase, kp, r, pn) + col; a += *(const f32x4*)sp; b += *(const f32x4*)(sp + 4); }
    u32x4 w; w.x = cvt_pk_bf16(a[0], a[1]); w.y = cvt_pk_bf16(a[2], a[3]); w.z = cvt_pk_bf16(b[0], b[1]); w.w = cvt_pk_bf16(b[2], b[3]); return w;
}
struct EpiUp {
    static constexpr bool PERM = true; static constexpr int HOOK_T = -1;
    bf16_t *AU, *GB; float* YB;
    __device__ __forceinline__ void mid(f32x4 (&)[2][2][4][2], const Unit&, int, int, int, int) const {}
    __device__ __forceinline__ void operator()(const f32x4 (&acc)[2][2][4][2], const Unit& u, int wr, int wc, int fr, int fq) const {
        asm volatile("" : "+v"(fr), "+v"(fq));
        const int row0 = u.pm * 256 + wr * 64 + fr; const int cl = wc * 32 + 8 * fq;
        if (u.nkt != 16) {
#pragma unroll
            for (int ai = 0; ai < 2; ++ai)
#pragma unroll
                for (int m = 0; m < 4; ++m) { const int r = row0 + ai * 128 + m * 16 - T_PROMPT; float* sp = up_slab(YB, u.kt0 >> 2, r, u.pn);
#pragma unroll
                    for (int bj = 0; bj < 2; ++bj) { *(f32x4*)(sp + bj * 128 + cl) = acc[ai][bj][m][0]; *(f32x4*)(sp + bj * 128 + cl + 4) = acc[ai][bj][m][1]; } }
            return;
        }
        bf16_t* base = (u.pn < 11) ? AU + u.pn * 256 : GB + (u.pn - 11) * 256;
#pragma unroll
        for (int ai = 0; ai < 2; ++ai)
#pragma unroll
            for (int m = 0; m < 4; ++m) { const int row = row0 + ai * 128 + m * 16;
#pragma unroll
                for (int bj = 0; bj < 2; ++bj) store8(base + (size_t)row * DFF + bj * 128 + cl, acc[ai][bj][m][0], acc[ai][bj][m][1]); }
    }
};
struct EpiDown {
    static constexpr bool PERM = false; static constexpr int HOOK_T = -1;
    const bf16_t* X1; const float *bias, *mod; float* Z; float* ZS;
    __device__ __forceinline__ void mid(f32x4 (&)[2][2][4][2], const Unit&, int, int, int, int) const {}
    __device__ __forceinline__ void operator()(const f32x4 (&acc)[2][2][4][2], const Unit& u, int wr, int wc, int fr, int fq) const {
        asm volatile("" : "+v"(fr), "+v"(fq));
        const int row0 = u.pm * 256 + wr * 64 + fr, col0 = u.pn * 256 + wc * 32 + 4 * fq;
#pragma unroll
        for (int ai = 0; ai < 2; ++ai)
#pragma unroll
            for (int m = 0; m < 4; ++m) { const int row = row0 + ai * 128 + m * 16; const int s = row_seq(row);
                const float* gc = mod + (size_t)s * 6144 + 5120;
#pragma unroll
                for (int bj = 0; bj < 2; ++bj)
#pragma unroll
                    for (int n = 0; n < 2; ++n) { const int c = col0 + bj * 128 + n * 16;
                        const u32x2 xw = *(const u32x2*)(X1 + (size_t)row * 1024 + c); const f32x4 bo = *(const f32x4*)(bias + c), gg = *(const f32x4*)(gc + c);
                        const f32x4 x1 = (f32x4){bf_lo(xw.x), bf_hi(xw.x), bf_lo(xw.y), bf_hi(xw.y)};
                        if (u.nkt != 44) { f32x4 v = gg * acc[ai][bj][m][n]; if (u.kt0 == 0) v += x1 * ALPHA + gg * bo;
                            *(f32x4*)(ZS + (size_t)(u.kt0 >> 2) * (512 * 1024) + (size_t)(row - T_PROMPT) * 1024 + c) = v; }
                        else *(f32x4*)(Z + (size_t)row * 1024 + c) = x1 * ALPHA + gg * (acc[ai][bj][m][n] + bo); }
                asm volatile("" ::: "memory"); }
    }
};

__device__ __forceinline__ int win_src_col(int n) {
    if (n < 4096) return n;
    if (n < 4352) return 6144 + (n - 4096);
    if (n < 6400) return 4096 + (n - 4352);
    if (n < 7168) return 6144 + 256 + (n - 6400);
    const int base = n < 9216 ? 7168 : 9216; const int r = n - base, p = r >> 8, w = r & 255;
    return w < 128 ? base + 128 * p + w : base + 1024 + 128 * p + (w - 128);
}
__device__ __forceinline__ void transpose_item(const float* W, int N, int k0, int nsrc0, bf16_t* WT, int ldk, int drow0, int kofs, LAS float* scr, int lane) {
    float tv[32];
#pragma unroll
    for (int i = 0; i < 32; ++i) tv[i] = W[(size_t)(k0 + 2 * i + (lane >> 5)) * N + nsrc0 + (lane & 31)];
#pragma unroll
    for (int i = 0; i < 32; ++i) scr[(2 * i + (lane >> 5)) * 33 + (lane & 31)] = tv[i];
    asm volatile("s_waitcnt lgkmcnt(0)" ::: "memory");
    const int c = lane & 7;
#pragma unroll
    for (int j = 0; j < 4; ++j) { const int n = (lane >> 3) + 8 * j; const LAS float* s = scr + (8 * c) * 33 + n;
        u32x4 o; o.x = cvt_pk_bf16(s[0 * 33], s[1 * 33]); o.y = cvt_pk_bf16(s[2 * 33], s[3 * 33]); o.z = cvt_pk_bf16(s[4 * 33], s[5 * 33]); o.w = cvt_pk_bf16(s[6 * 33], s[7 * 33]);
        *(u32x4*)(WT + (size_t)(drow0 + n) * ldk + kofs + k0 + 8 * c) = o; }
    asm volatile("s_waitcnt lgkmcnt(0)" ::: "memory");
}
__device__ __forceinline__ void phase0(const Params& p, LAS unsigned char* lds) {
    const int tid = threadIdx.x, wave = __builtin_amdgcn_readfirstlane(tid >> 6), lane = tid & 63;
    const int gw = blockIdx.x * 8 + wave, NGW = gridDim.x * 8;
    unsigned char* ws = p.ws;
    LAS float* scr = (LAS float*)(lds + wave * 8704);
    float* modp = (float*)(ws + OFF_MODP);
    constexpr int I_MOD = 1536, I_IN = 16 * 352, I_ORET = 32 * 32, I_OCONV = 16 * 32, I_OUT = 16 * 32, I_UP = 16 * 176, I_DOWN = 44 * 32;
    constexpr int NITEMS = I_MOD + I_IN + I_ORET + I_OCONV + I_OUT + I_UP + I_DOWN;
    for (int it = gw; it < NITEMS; it += NGW) {
        int r = it;
        if (r < I_MOD) {
            const int cgp = r % 96, kc = r / 96, n = cgp * 64 + lane, kb = kc * 64;
            float a[32];
#pragma unroll
            for (int s = 0; s < 32; ++s) a[s] = 0.f;
#pragma unroll 1
            for (int kq = 0; kq < 64; kq += 16) {
                float w[16];
#pragma unroll
                for (int j = 0; j < 16; ++j) w[j] = p.w_mod[(size_t)(kb + kq + j) * 6144 + n];
#pragma unroll
                for (int k = 0; k < 16; k += 4) {
#pragma unroll
                    for (int s = 0; s < 32; ++s) { const float* cp = (s < 16 ? p.c_prompt + s * 1024 : p.c_sample + (s - 16) * 1024) + kb + kq + k; const f32x4 cv = *(const f32x4*)cp;
                        a[s] += cv[0] * w[k] + cv[1] * w[k + 1] + cv[2] * w[k + 2] + cv[3] * w[k + 3]; }
                }
            }
#pragma unroll
            for (int s = 0; s < 32; ++s) modp[((size_t)kc * 32 + s) * 6144 + n] = a[s];
            continue;
        }
        r -= I_MOD;
        const float* W; int N, k0, nsrc0, ldk, drow0, kofs; bf16_t* WT;
        if (r < I_IN) { const int kb = r / 352, nb = r % 352; W = p.w_in; N = 11264; k0 = kb * 64; nsrc0 = win_src_col(nb * 32); WT = (bf16_t*)(ws + OFF_WIN); ldk = 1024; drow0 = nb * 32; kofs = 0; }
        else { r -= I_IN;
        if (r < I_ORET) { const int kb = r / 32, nb = r % 32; W = p.w_o_ret; N = 1024; k0 = kb * 64; nsrc0 = nb * 32; WT = (bf16_t*)(ws + OFF_WCAT); ldk = 3072; drow0 = nb * 32; kofs = 0; }
        else { r -= I_ORET;
        if (r < I_OCONV) { const int kb = r / 32, nb = r % 32; W = p.w_o_conv; N = 1024; k0 = kb * 64; nsrc0 = nb * 32; WT = (bf16_t*)(ws + OFF_WCAT); ldk = 3072; drow0 = nb * 32; kofs = 2048; }
        else { r -= I_OCONV;
        if (r < I_OUT) { const int kb = r / 32, nb = r % 32; W = p.w_out; N = 1024; k0 = kb * 64; nsrc0 = nb * 32; WT = (bf16_t*)(ws + OFF_WOUT); ldk = 1024; drow0 = nb * 32; kofs = 0; }
        else { r -= I_OUT;
        if (r < I_UP) { const int kb = r / 176, nb = r % 176; W = p.w_up; N = 5632; k0 = kb * 64; nsrc0 = nb * 32; WT = (bf16_t*)(ws + OFF_WUP); ldk = 1024; drow0 = nb * 32; kofs = 0; }
        else { r -= I_UP; const int kb = r / 32, nb = r % 32; W = p.w_down; N = 1024; k0 = kb * 64; nsrc0 = nb * 32; WT = (bf16_t*)(ws + OFF_WDOWN); ldk = 2816; drow0 = nb * 32; kofs = 0; } } } } }
        transpose_item(W, N, k0, nsrc0, WT, ldk, drow0, kofs, scr, lane);
    }
    float* rot = (float*)(ws + OFF_ROT);
    for (int idx = blockIdx.x * 512 + tid; idx < 2080 * 128; idx += gridDim.x * 512) {
        const int pos = idx >> 7, i = idx & 127;
        const float invf = exp2f(-(float)i * (13.287712379549449f / 128.0f));
        double rev = (double)pos * (double)invf * 0.15915494309189535; rev -= rint(rev);
        const float f = (float)rev;
        rot[2 * idx] = __builtin_amdgcn_cosf(f); rot[2 * idx + 1] = __builtin_amdgcn_sinf(f);
    }
}

__device__ __forceinline__ void phase1(const Params& p, LAS unsigned char* lds) {
    const int tid = threadIdx.x, wave = tid >> 6, lane = tid & 63;
    unsigned char* ws = p.ws;
    const float* modp = (const float*)(ws + OFF_MODP); float* mod = (float*)(ws + OFF_MOD); float* lnst = (float*)(ws + OFF_LNST);
    bf16_t* H = (bf16_t*)p.out;
    for (int i = blockIdx.x * 512 + tid; i < 32 * 6144; i += gridDim.x * 512) { const int n = i % 6144; float v = p.b_mod[n];
#pragma unroll
        for (int kc = 0; kc < 16; ++kc) v += modp[(size_t)kc * 32 * 6144 + i];
        mod[i] = v; }
    LAS float* lm = (LAS float*)lds;
    int s_have = -1;
    for (int grp = (int)(((long)blockIdx.x * 1040) / gridDim.x), gend = (int)(((long)(blockIdx.x + 1) * 1040) / gridDim.x); grp < gend; ++grp) {
        const int s = grp < 1024 ? (grp >> 6) : 16 + (grp - 1024);
        if (s != s_have) {
#pragma unroll
            for (int j = 0; j < 4; ++j) { const int idx = tid + 512 * j; float v = p.b_mod[idx];
#pragma unroll
                for (int kc = 0; kc < 16; ++kc) v += modp[((size_t)kc * 32 + s) * 6144 + idx];
                lm[idx] = v; }
            s_have = s;
        }
        __syncthreads();
        {
            const int rowb = grp * 32 + wave * 4;
            f32x4 v[4][4]; float mean[4], rstd[4];
#pragma unroll
            for (int rr = 0; rr < 4; ++rr) { const int row = rowb + rr;
                const float* xr = row < T_PROMPT ? p.x_prompt + (size_t)row * 1024 : p.x_sample + (size_t)(row - T_PROMPT) * 1024;
#pragma unroll
                for (int j = 0; j < 4; ++j) v[rr][j] = ((const f32x4*)xr)[lane + 64 * j]; }
#pragma unroll
            for (int rr = 0; rr < 4; ++rr) { float sm = 0.f;
#pragma unroll
                for (int j = 0; j < 4; ++j) sm += (v[rr][j][0] + v[rr][j][1]) + (v[rr][j][2] + v[rr][j][3]);
                mean[rr] = wave_sum(sm) * (1.0f / 1024.0f); float s2 = 0.f;
#pragma unroll
                for (int j = 0; j < 4; ++j) { v[rr][j] = v[rr][j] - mean[rr]; s2 += (v[rr][j][0] * v[rr][j][0] + v[rr][j][1] * v[rr][j][1]) + (v[rr][j][2] * v[rr][j][2] + v[rr][j][3] * v[rr][j][3]); }
                rstd[rr] = 1.0f / sqrtf(wave_sum(s2) * (1.0f / 1024.0f) + LN_EPS); }
#pragma unroll
            for (int j = 0; j < 4; ++j) { const int c = 4 * (lane + 64 * j);
                const f32x4 gv = *(const f32x4*)(p.ln_in_g + c), bv = *(const f32x4*)(p.ln_in_b + c);
                const f32x4 sh = *(const LAS f32x4*)(lm + c), sc = *(const LAS f32x4*)(lm + 1024 + c);
#pragma unroll
                for (int rr = 0; rr < 4; ++rr) { const f32x4 xl = v[rr][j] * rstd[rr] * gv + bv; const f32x4 h = xl * (sc + 1.0f) + sh;
                    u32x2 w; w.x = cvt_pk_bf16(h[0], h[1]); w.y = cvt_pk_bf16(h[2], h[3]);
                    *(u32x2*)(H + (size_t)(rowb + rr) * 1024 + c) = w; } }
            if (lane < 4) { lnst[2 * (rowb + lane)] = lane == 0 ? mean[0] : lane == 1 ? mean[1] : lane == 2 ? mean[2] : mean[3];
                            lnst[2 * (rowb + lane) + 1] = lane == 0 ? rstd[0] : lane == 1 ? rstd[1] : lane == 2 ? rstd[2] : rstd[3]; }
        }
        __syncthreads();
    }
}

constexpr int RT_QS = 264, RT_TS = 72;
#define LDS_BARRIER() do { asm volatile("s_waitcnt lgkmcnt(0)" ::: "memory"); __builtin_amdgcn_s_barrier(); asm volatile("" ::: "memory"); } while (0)
__device__ __forceinline__ void phase_retention(const Params& p, LAS unsigned char* lds, const bool dry) {
    const int tid0 = threadIdx.x, w = __builtin_amdgcn_readfirstlane(tid0 >> 6), l0 = tid0 & 63;
    unsigned char* ws = p.ws;
    const bf16_t* Qg = (const bf16_t*)(ws + OFF_Q); const bf16_t* Kg = (const bf16_t*)(ws + OFF_K);
    bf16_t* ACAT = (bf16_t*)(ws + OFF_ACAT); float* rst = (float*)(ws + OFF_RST);
    LAS bf16_t* Qn = (LAS bf16_t*)lds; LAS bf16_t* Kn = Qn + 64 * RT_QS; LAS bf16_t* KT = Kn + 64 * RT_QS;
    LAS bf16_t* VT = KT + 256 * RT_TS; LAS bf16_t* Pm = VT + 128 * RT_TS; LAS float* red = (LAS float*)(Pm + 64 * RT_TS);
    for (int item = blockIdx.x; item < 512; item += gridDim.x) {
        const bool samp = item >= 256; const int it = item & 255, xcd = it & 7, slot = it >> 3, sl = slot & 3, pr = (slot >> 2) * 8 + xcd, b = pr >> 2, h = pr & 3;
        const int Lc = samp ? 32 : 64, nch = samp ? 1 : 32;
        const size_t row0 = samp ? (size_t)(T_PROMPT + b * 32) : (size_t)b * 2048;
        const float lg2 = log2f(1.0f - exp2f(-5.0f - (float)h));
        const int ecol = h * 512 + sl * 128;
        f32x4 S[16];
        { const int l = l0, fr = l & 15, g = l >> 4;
        if (samp) { const float* sp = p.state_ret + ((size_t)(b * 4 + h) * 256) * 512 + sl * 128 + 16 * w + fr;
#pragma unroll
            for (int T = 0; T < 16; ++T)
#pragma unroll
                for (int i = 0; i < 4; ++i) S[T][i] = sp[(size_t)(16 * T + 4 * g + i) * 512];
        } else {
#pragma unroll
            for (int T = 0; T < 16; ++T) S[T] = (f32x4){0.f, 0.f, 0.f, 0.f};
        } }
        u32x4 rq[4], rk[4], rv[2];
#define RT_IDX int l = l0; asm volatile("" : "+v"(l)); const int tid = w * 64 + l, fr = l & 15, g = l >> 4; \
        const int k_dc = w * 4 + (l & 3), k_tpl = (l >> 2) & 15; const int v_ec = (w & 3) * 4 + (l & 3), v_tp = (w >> 2) * 16 + ((l >> 2) & 15); (void)tid; (void)fr; (void)g; (void)k_dc; (void)k_tpl; (void)v_ec; (void)v_tp;
#define RT_LOAD(c) do { const size_t rb = row0 + (size_t)(c) * 64; \
            _Pragma("unroll") for (int j = 0; j < 4; ++j) { const int idx = tid + 512 * j, tok = idx >> 5, ch = idx & 31; \
                rq[j] = tok < Lc ? *(const u32x4*)(Qg + (rb + tok) * 1024 + h * 256 + ch * 8) : (u32x4){0u, 0u, 0u, 0u}; } \
            _Pragma("unroll") for (int j = 0; j < 2; ++j) { const int t0 = 2 * (j * 16 + k_tpl); \
                rk[2 * j] = t0 < Lc ? *(const u32x4*)(Kg + (rb + t0) * 1024 + h * 256 + k_dc * 8) : (u32x4){0u, 0u, 0u, 0u}; \
                rk[2 * j + 1] = t0 + 1 < Lc ? *(const u32x4*)(Kg + (rb + t0 + 1) * 1024 + h * 256 + k_dc * 8) : (u32x4){0u, 0u, 0u, 0u}; } \
            { const int t0 = 2 * v_tp; \
              rv[0] = t0 < Lc ? *(const u32x4*)(ACAT + (rb + t0) * 3072 + ecol + v_ec * 8) : (u32x4){0u, 0u, 0u, 0u}; \
              rv[1] = t0 + 1 < Lc ? *(const u32x4*)(ACAT + (rb + t0 + 1) * 3072 + ecol + v_ec * 8) : (u32x4){0u, 0u, 0u, 0u}; } } while (0)
        { RT_IDX RT_LOAD(0); }
        const float sdec = exp2f(lg2 * (float)Lc);
        for (int c = 0; c < nch; ++c) {
            RT_IDX
            LDS_BARRIER();
#pragma unroll
            for (int j = 0; j < 4; ++j) { const int idx = tid + 512 * j, tok = idx >> 5, ch = idx & 31; *(LAS u32x4*)(Qn + tok * RT_QS + ch * 8) = rq[j]; }
#pragma unroll
            for (int j = 0; j < 2; ++j) { const int tp = j * 16 + k_tpl, t0 = 2 * tp;
                *(LAS u32x4*)(Kn + t0 * RT_QS + k_dc * 8) = rk[2 * j]; *(LAS u32x4*)(Kn + (t0 + 1) * RT_QS + k_dc * 8) = rk[2 * j + 1];
                const float f0 = exp2f(lg2 * (float)(Lc - 1 - t0)), f1 = exp2f(lg2 * (float)(Lc - 2 - t0));
#pragma unroll
                for (int q = 0; q < 4; ++q) { const unsigned a = rk[2 * j][q], bb = rk[2 * j + 1][q];
                    *(LAS unsigned*)(KT + (k_dc * 8 + 2 * q) * RT_TS + t0) = cvt_pk_bf16(bf_lo(a) * f0, bf_lo(bb) * f1);
                    *(LAS unsigned*)(KT + (k_dc * 8 + 2 * q + 1) * RT_TS + t0) = cvt_pk_bf16(bf_hi(a) * f0, bf_hi(bb) * f1); } }
            { const int t0 = 2 * v_tp;
#pragma unroll
                for (int q = 0; q < 4; ++q) { const unsigned a = rv[0][q], bb = rv[1][q];
                    *(LAS unsigned*)(VT + (v_ec * 8 + 2 * q) * RT_TS + t0) = (a & 0xffffu) | (bb << 16);
                    *(LAS unsigned*)(VT + (v_ec * 8 + 2 * q + 1) * RT_TS + t0) = (a >> 16) | (bb & 0xffff0000u); } }
            if (c + 1 < nch) RT_LOAD(c + 1);
            LDS_BARRIER();
            { const int qi = w >> 1;
#pragma unroll
                for (int tj = 0; tj < 2; ++tj) { const int kj = (w & 1) * 2 + tj; f32x4 d = (f32x4){0.f, 0.f, 0.f, 0.f};
                    if (kj <= qi) {
#pragma unroll
                        for (int ks = 0; ks < 8; ++ks) { const bf16x8 af = *(const LAS bf16x8*)(Kn + (16 * kj + fr) * RT_QS + 32 * ks + 8 * g);
                            const bf16x8 bfv = *(const LAS bf16x8*)(Qn + (16 * qi + fr) * RT_QS + 32 * ks + 8 * g);
                            d = __builtin_amdgcn_mfma_f32_16x16x32_bf16(af, bfv, d, 0, 0, 0); }
                    }
                    const int qq = 16 * qi + fr, k0 = 16 * kj + 4 * g; float o[4];
#pragma unroll
                    for (int i = 0; i < 4; ++i) { const int dk = qq - (k0 + i); o[i] = dk >= 0 ? d[i] * exp2f(lg2 * (float)dk) : 0.f; }
                    u32x2 pw; pw.x = cvt_pk_bf16(o[0], o[1]); pw.y = cvt_pk_bf16(o[2], o[3]);
                    *(LAS u32x2*)(Pm + qq * RT_TS + k0) = pw; } }
            LDS_BARRIER();
            bf16x8 Bv[2];
#pragma unroll
            for (int ks = 0; ks < 2; ++ks) Bv[ks] = *(const LAS bf16x8*)(VT + (16 * w + fr) * RT_TS + 32 * ks + 8 * g);
            f32x4 oacc[4];
#pragma unroll
            for (int mi = 0; mi < 4; ++mi) oacc[mi] = (f32x4){0.f, 0.f, 0.f, 0.f};
            {
                u32x2 qb[2][4][2];
#pragma unroll
                for (int mi = 0; mi < 4; ++mi) { qb[0][mi][0] = *(const LAS u32x2*)(Qn + (16 * mi + fr) * RT_QS + 4 * g); qb[0][mi][1] = *(const LAS u32x2*)(Qn + (16 * mi + fr) * RT_QS + 16 + 4 * g); }
#pragma unroll
                for (int ks = 0; ks < 8; ++ks) {
                    if (ks + 1 < 8) {
#pragma unroll
                        for (int mi = 0; mi < 4; ++mi) { qb[(ks + 1) & 1][mi][0] = *(const LAS u32x2*)(Qn + (16 * mi + fr) * RT_QS + 32 * (ks + 1) + 4 * g);
                            qb[(ks + 1) & 1][mi][1] = *(const LAS u32x2*)(Qn + (16 * mi + fr) * RT_QS + 32 * (ks + 1) + 16 + 4 * g); } }
                    union { bf16x8 v; unsigned u[4]; } sb;
                    sb.u[0] = cvt_pk_bf16(S[2 * ks][0], S[2 * ks][1]); sb.u[1] = cvt_pk_bf16(S[2 * ks][2], S[2 * ks][3]);
                    sb.u[2] = cvt_pk_bf16(S[2 * ks + 1][0], S[2 * ks + 1][1]); sb.u[3] = cvt_pk_bf16(S[2 * ks + 1][2], S[2 * ks + 1][3]);
#pragma unroll
                    for (int mi = 0; mi < 4; ++mi) { union { bf16x8 v; u32x2 h2[2]; } qa; qa.h2[0] = qb[ks & 1][mi][0]; qa.h2[1] = qb[ks & 1][mi][1];
                        oacc[mi] = __builtin_amdgcn_mfma_f32_16x16x32_bf16(qa.v, sb.v, oacc[mi], 0, 0, 0); }
                }
            }
#pragma unroll
            for (int mi = 0; mi < 4; ++mi)
#pragma unroll
                for (int i = 0; i < 4; ++i) oacc[mi][i] *= exp2f(lg2 * (float)(16 * mi + 4 * g + i + 1));
#pragma unroll
            for (int mi = 0; mi < 4; ++mi) {
#pragma unroll
                for (int ks = 0; ks < 2; ++ks) { const bf16x8 af = *(const LAS bf16x8*)(Pm + (16 * mi + fr) * RT_TS + 32 * ks + 8 * g);
                    oacc[mi] = __builtin_amdgcn_mfma_f32_16x16x32_bf16(af, Bv[ks], oacc[mi], 0, 0, 0); }
            }
            __builtin_amdgcn_sched_barrier(0);
#pragma unroll
            for (int mi = 0; mi < 4; ++mi)
#pragma unroll
                for (int i = 0; i < 4; ++i) Kn[(16 * mi + 4 * g + i) * 136 + 16 * w + fr] = (bf16_t)(cvt_pk_bf16(oacc[mi][i], 0.f) & 0xffffu);
            __builtin_amdgcn_sched_barrier(0);
            {
                bf16x8 kf[2][2];
#pragma unroll
                for (int ks = 0; ks < 2; ++ks) kf[0][ks] = *(const LAS bf16x8*)(KT + fr * RT_TS + 32 * ks + 8 * g);
#pragma unroll
                for (int T = 0; T < 16; ++T) {
                    if (T + 1 < 16) {
#pragma unroll
                        for (int ks = 0; ks < 2; ++ks) kf[(T + 1) & 1][ks] = *(const LAS bf16x8*)(KT + (16 * (T + 1) + fr) * RT_TS + 32 * ks + 8 * g); }
                    S[T] *= sdec;
#pragma unroll
                    for (int ks = 0; ks < 2; ++ks) S[T] = __builtin_amdgcn_mfma_f32_16x16x32_bf16(kf[T & 1][ks], Bv[ks], S[T], 0, 0, 0);
                }
            }
            LDS_BARRIER();
            { const int q = tid >> 3, seg = tid & 7;
              const u32x4 v0 = *(const LAS u32x4*)(Kn + q * 136 + 16 * seg), v1 = *(const LAS u32x4*)(Kn + q * 136 + 16 * seg + 8);
              float s1 = 0.f, s2 = 0.f;
#pragma unroll
              for (int e = 0; e < 4; ++e) { const float a0 = bf_lo(v0[e]), a1 = bf_hi(v0[e]), b0 = bf_lo(v1[e]), b1 = bf_hi(v1[e]);
                  s1 += (a0 + a1) + (b0 + b1); s2 += (a0 * a0 + a1 * a1) + (b0 * b0 + b1 * b1); }
#pragma unroll
              for (int off = 1; off < 8; off <<= 1) { s1 += __shfl_xor(s1, off); s2 += __shfl_xor(s2, off); }
              if (q < Lc && !dry) { const size_t row = row0 + (size_t)c * 64 + q;
                  bf16_t* op = ACAT + row * 3072 + ecol + 16 * seg; *(u32x4*)op = v0; *(u32x4*)(op + 8) = v1;
                  if (seg == 0) { float* dst = rst + ((row * 4 + h) * 4 + sl) * 2; dst[0] = s1; dst[1] = s2; } } }
        }
#undef RT_LOAD
#undef RT_IDX
        { const int l = l0, fr = l & 15, g = l >> 4; float* so = p.out + (samp ? OUT_RETS : OUT_RETP) + ((size_t)(b * 4 + h) * 256) * 512 + sl * 128 + 16 * w + fr;
#pragma unroll
            for (int T = 0; T < 16; ++T)
#pragma unroll
                for (int i = 0; i < 4; ++i) if (!dry) so[(size_t)(16 * T + 4 * g + i) * 512] = S[T][i]; }
    }
}

__device__ __forceinline__ void unpack8(const u32x4 w, float (&f)[8]) {
#pragma unroll
    for (int q = 0; q < 4; ++q) { f[2 * q] = bf_lo(w[q]); f[2 * q + 1] = bf_hi(w[q]); }
}
__device__ __forceinline__ void phase_mix_elem(const Params& p, const bool dry) {
    unsigned char* ws = p.ws;
    bf16_t* ACAT = (bf16_t*)(ws + OFF_ACAT); const bf16_t* G = (const bf16_t*)(ws + OFF_G); const bf16_t* U = (const bf16_t*)(ws + OFF_U);
    const float* rst = (const float*)(ws + OFF_RST);
    const int gt = blockIdx.x * 512 + threadIdx.x; const int NS = (gridDim.x * 512) / 384; const int stream = gt / 384, cc = gt % 384;
    if (stream >= NS) return;
    const int rows_per = (T_ALL + NS - 1) / NS; const int r0 = stream * rows_per; const int r1 = min(r0 + rows_per, T_ALL);
    if (cc < 256) {
        const int j = cc >> 6, col = 8 * cc;
        for (int rb = r0; rb < r1; rb += 4) {
            u32x4 ov[4], gv[4]; f32x4 sa[4], sb[4];
#pragma unroll
            for (int i = 0; i < 4; ++i) { const int row = min(rb + i, r1 - 1);
                ov[i] = *(const u32x4*)(ACAT + (size_t)row * 3072 + col); gv[i] = *(const u32x4*)(G + (size_t)row * 2048 + col);
                const float* st = rst + ((size_t)row * 4 + j) * 8; sa[i] = *(const f32x4*)st; sb[i] = *(const f32x4*)(st + 4); }
#pragma unroll
            for (int i = 0; i < 4; ++i) { const int row = rb + i;
                const float s1 = (sa[i][0] + sa[i][2]) + (sb[i][0] + sb[i][2]), s2 = (sa[i][1] + sa[i][3]) + (sb[i][1] + sb[i][3]);
                const float mu = s1 * (1.0f / 512.0f); const float var = fmaxf(s2 * (1.0f / 512.0f) - mu * mu, 0.f); const float rstd = 1.0f / sqrtf(var + LN_EPS);
                u32x4 r;
#pragma unroll
                for (int q = 0; q < 4; ++q) { const float g0 = bf_lo(gv[i][q]), g1 = bf_hi(gv[i][q]);
                    const float a0 = g0 * sigmoidf_(g0) * ((bf_lo(ov[i][q]) - mu) * rstd), a1 = g1 * sigmoidf_(g1) * ((bf_hi(ov[i][q]) - mu) * rstd);
                    r[q] = cvt_pk_bf16(a0, a1); }
                if (row < r1 && !dry) *(u32x4*)(ACAT + (size_t)row * 3072 + col) = r; }
        }
    } else {
        const int c = 8 * (cc - 256);
        float cb[8], w0[8], w1[8], w2[8], um1[8], um2[8];
#pragma unroll
        for (int e = 0; e < 8; ++e) { cb[e] = p.conv_b[c + e]; w0[e] = p.conv_w[c + e]; w1[e] = p.conv_w[1024 + c + e]; w2[e] = p.conv_w[2048 + c + e]; um1[e] = 0.f; um2[e] = 0.f; }
        { const int row = r0; const bool samp = row >= T_PROMPT; const int t = samp ? ((row - T_PROMPT) & 31) : (row & 2047); const int bl = samp ? ((row - T_PROMPT) >> 5) : (row >> 11);
          if (t >= 1) unpack8(*(const u32x4*)(U + (size_t)(row - 1) * 1024 + c), um1);
          if (t >= 2) unpack8(*(const u32x4*)(U + (size_t)(row - 2) * 1024 + c), um2);
          else if (t == 1 && samp) {
#pragma unroll
              for (int e = 0; e < 8; ++e) um2[e] = p.state_conv[((size_t)bl * 2 + 1) * 1024 + c + e]; } }
        for (int rb = r0; rb < r1; rb += 4) {
            u32x4 bg[4], uv[4];
#pragma unroll
            for (int i = 0; i < 4; ++i) { const int row = min(rb + i, r1 - 1);
                bg[i] = *(const u32x4*)(ACAT + (size_t)row * 3072 + 2048 + c); uv[i] = *(const u32x4*)(U + (size_t)row * 1024 + c); }
#pragma unroll
            for (int i = 0; i < 4; ++i) { const int row = rb + i;
                if (row < r1) {
                    const bool samp = row >= T_PROMPT; const int t = samp ? ((row - T_PROMPT) & 31) : (row & 2047); const int L = samp ? 32 : 2048; const int bl = samp ? ((row - T_PROMPT) >> 5) : (row >> 11);
                    if (t == 0) {
#pragma unroll
                        for (int e = 0; e < 8; ++e) { um1[e] = samp ? p.state_conv[((size_t)bl * 2 + 1) * 1024 + c + e] : 0.f; um2[e] = samp ? p.state_conv[((size_t)bl * 2) * 1024 + c + e] : 0.f; } }
                    float uc[8], bgf[8], res[8]; unpack8(uv[i], uc); unpack8(bg[i], bgf);
#pragma unroll
                    for (int e = 0; e < 8; ++e) { res[e] = bgf[e] * (cb[e] + w0[e] * um2[e] + w1[e] * um1[e] + w2[e] * uc[e]); um2[e] = um1[e]; um1[e] = uc[e]; }
                    if (!dry) { u32x4 r; r.x = cvt_pk_bf16(res[0], res[1]); r.y = cvt_pk_bf16(res[2], res[3]); r.z = cvt_pk_bf16(res[4], res[5]); r.w = cvt_pk_bf16(res[6], res[7]);
                        *(u32x4*)(ACAT + (size_t)row * 3072 + 2048 + c) = r;
                        if (t >= L - 2) { float* so = p.out + (samp ? OUT_CONVS : OUT_CONVP) + ((size_t)bl * 2 + (t - (L - 2))) * 1024 + c;
                            *(f32x4*)so = (f32x4){uc[0], uc[1], uc[2], uc[3]}; *(f32x4*)(so + 4) = (f32x4){uc[4], uc[5], uc[6], uc[7]}; } }
                } }
        }
    }
}

__device__ __forceinline__ void phase_ln1(const Params& p, const bool dry) {
    const int tid = threadIdx.x, wave = tid >> 6, lane = tid & 63;
    unsigned char* ws = p.ws;
    const float* mod = (const float*)(ws + OFF_MOD); bf16_t* X1 = (bf16_t*)(ws + OFF_X1);
    for (int rowb = (blockIdx.x * 8 + wave) * 4; rowb < T_ALL; rowb += gridDim.x * 32) {
        const int s = row_seq(rowb);
        f32x4 v[4][4]; float rstd[4];
#pragma unroll
        for (int rr = 0; rr < 4; ++rr)
#pragma unroll
            for (int j = 0; j < 4; ++j) {
                if (rowb < T_PROMPT) v[rr][j] = ((const f32x4*)(p.out + (size_t)(rowb + rr) * 1024))[lane + 64 * j];
                else { const float* zs = (const float*)(ws + OFF_MS32) + (size_t)(rowb + rr - T_PROMPT) * 1024;
                    v[rr][j] = (((const f32x4*)zs)[lane + 64 * j] + ((const f32x4*)(zs + 512 * 1024))[lane + 64 * j]) + (((const f32x4*)(zs + 2 * 512 * 1024))[lane + 64 * j] + ((const f32x4*)(zs + 3 * 512 * 1024))[lane + 64 * j]); } }
#pragma unroll
        for (int rr = 0; rr < 4; ++rr) { float sm = 0.f;
#pragma unroll
            for (int j = 0; j < 4; ++j) sm += (v[rr][j][0] + v[rr][j][1]) + (v[rr][j][2] + v[rr][j][3]);
            const float mean = wave_sum(sm) * (1.0f / 1024.0f); float s2 = 0.f;
#pragma unroll
            for (int j = 0; j < 4; ++j) { v[rr][j] = v[rr][j] - mean; s2 += (v[rr][j][0] * v[rr][j][0] + v[rr][j][1] * v[rr][j][1]) + (v[rr][j][2] * v[rr][j][2] + v[rr][j][3] * v[rr][j][3]); }
            rstd[rr] = 1.0f / sqrtf(wave_sum(s2) * (1.0f / 1024.0f) + LN_EPS); }
#pragma unroll
        for (int j = 0; j < 4; ++j) { const int c = 4 * (lane + 64 * j);
            const f32x4 gv = *(const f32x4*)(p.ln1_g + c), bv = *(const f32x4*)(p.ln1_b + c);
            const f32x4 sh = *(const f32x4*)(mod + (size_t)s * 6144 + 3072 + c), sc = *(const f32x4*)(mod + (size_t)s * 6144 + 4096 + c);
#pragma unroll
            for (int rr = 0; rr < 4; ++rr) { const int row = rowb + rr;
                const f32x4 x1 = v[rr][j] * rstd[rr] * gv + bv; const f32x4 hh = x1 * (sc + 1.0f) + sh;
                u32x2 w; w.x = cvt_pk_bf16(x1[0], x1[1]); w.y = cvt_pk_bf16(x1[2], x1[3]);
                u32x2 w2; w2.x = cvt_pk_bf16(hh[0], hh[1]); w2.y = cvt_pk_bf16(hh[2], hh[3]);
                if (!dry) { *(u32x2*)(X1 + (size_t)row * 1024 + c) = w; *(u32x2*)((bf16_t*)p.out + (size_t)row * 2048 + c) = w2; } } }
    }
}

__device__ __forceinline__ void phase_ffn_elem(const Params& p, const bool dry) {
    unsigned char* ws = p.ws;
    const bf16_t* AU = (const bf16_t*)(ws + OFF_AU); bf16_t* GBF = (bf16_t*)(ws + OFF_GBF);
    const int gt = blockIdx.x * 512 + threadIdx.x; const int NS = (gridDim.x * 512) / 352; const int stream = gt / 352, cc = gt % 352;
    if (stream >= NS) return;
    constexpr int UNITS = T_PROMPT + 6 * (T_ALL - T_PROMPT);
    const int u0 = (int)(((long)stream * UNITS) / NS), u1 = (int)(((long)(stream + 1) * UNITS) / NS);
    const int r0 = u0 <= T_PROMPT ? u0 : T_PROMPT + (u0 - T_PROMPT + 5) / 6, r1 = u1 <= T_PROMPT ? u1 : T_PROMPT + (u1 - T_PROMPT + 5) / 6;
    if (r0 >= r1) return;
    const int c = 8 * cc;
    float cb[8], w0[8], w1[8], w2[8], am1[8], am2[8];
#pragma unroll
    for (int e = 0; e < 8; ++e) { cb[e] = p.ffn_conv_b[c + e]; w0[e] = p.ffn_conv_w[c + e]; w1[e] = p.ffn_conv_w[DFF + c + e]; w2[e] = p.ffn_conv_w[2 * DFF + c + e]; am1[e] = 0.f; am2[e] = 0.f; }
    { const int row = r0; const bool samp = row >= T_PROMPT; const int t = samp ? ((row - T_PROMPT) & 31) : (row & 2047); const int bl = samp ? ((row - T_PROMPT) >> 5) : (row >> 11);
      if (t >= 1) unpack8(samp ? up_slab_sum8(p.out, row - 1 - T_PROMPT, c >> 8, c & 255) : *(const u32x4*)(AU + (size_t)(row - 1) * DFF + c), am1);
      if (t >= 2) unpack8(samp ? up_slab_sum8(p.out, row - 2 - T_PROMPT, c >> 8, c & 255) : *(const u32x4*)(AU + (size_t)(row - 2) * DFF + c), am2);
      else if (t == 1 && samp) {
#pragma unroll
          for (int e = 0; e < 8; ++e) am2[e] = p.state_ffn[((size_t)bl * 2 + 1) * DFF + c + e]; } }
#define FFN_GROUP(REND, LOADS) \
    for (; rb < (REND); rb += 4) { \
        u32x4 av[4], gv[4]; \
        _Pragma("unroll") for (int i = 0; i < 4; ++i) { const int row = min(rb + i, (REND) - 1); LOADS } \
        _Pragma("unroll") for (int i = 0; i < 4; ++i) { const int row = rb + i; \
            if (row < (REND)) { \
                const bool samp = row >= T_PROMPT; const int t = samp ? ((row - T_PROMPT) & 31) : (row & 2047); const int L = samp ? 32 : 2048; const int bl = samp ? ((row - T_PROMPT) >> 5) : (row >> 11); \
                if (t == 0) { \
                    _Pragma("unroll") for (int e = 0; e < 8; ++e) { am1[e] = samp ? p.state_ffn[((size_t)bl * 2 + 1) * DFF + c + e] : 0.f; am2[e] = samp ? p.state_ffn[((size_t)bl * 2) * DFF + c + e] : 0.f; } } \
                float ac[8], gf[8], res[8]; unpack8(av[i], ac); unpack8(gv[i], gf); \
                _Pragma("unroll") for (int e = 0; e < 8; ++e) { res[e] = gelu_f(cb[e] + w0[e] * am2[e] + w1[e] * am1[e] + w2[e] * ac[e]) * gf[e]; am2[e] = am1[e]; am1[e] = ac[e]; } \
                if (!dry) { u32x4 r; r.x = cvt_pk_bf16(res[0], res[1]); r.y = cvt_pk_bf16(res[2], res[3]); r.z = cvt_pk_bf16(res[4], res[5]); r.w = cvt_pk_bf16(res[6], res[7]); \
                    *(u32x4*)(GBF + (size_t)row * DFF + c) = r; \
                    if (t >= L - 2) { float* so = p.out + (samp ? OUT_FFNS : OUT_FFNP) + ((size_t)bl * 2 + (t - (L - 2))) * DFF + c; \
                        *(f32x4*)so = (f32x4){ac[0], ac[1], ac[2], ac[3]}; *(f32x4*)(so + 4) = (f32x4){ac[4], ac[5], ac[6], ac[7]}; } } \
            } } \
    }
    int rb = r0;
    { const int rp = min(r1, T_PROMPT);
      FFN_GROUP(rp, av[i] = *(const u32x4*)(AU + (size_t)row * DFF + c); gv[i] = *(const u32x4*)(GBF + (size_t)row * DFF + c);) }
    rb = max(r0, T_PROMPT);
    FFN_GROUP(r1, av[i] = up_slab_sum8(p.out, row - T_PROMPT, c >> 8, c & 255); gv[i] = up_slab_sum8(p.out, row - T_PROMPT, 11 + (c >> 8), c & 255);)
#undef FFN_GROUP
}

__device__ __forceinline__ void phase_ln2(const Params& p, const bool dry) {
    const int tid = threadIdx.x, wave = tid >> 6, lane = tid & 63;
    for (int rowb = (blockIdx.x * 8 + wave) * 4; rowb < T_ALL; rowb += gridDim.x * 32) {
        f32x4 v[4][4]; float rstd[4];
#pragma unroll
        for (int rr = 0; rr < 4; ++rr)
#pragma unroll
            for (int j = 0; j < 4; ++j) {
                if (rowb < T_PROMPT) v[rr][j] = ((const f32x4*)(p.out + (size_t)(rowb + rr) * 1024))[lane + 64 * j];
                else { const float* zs = (const float*)(p.ws + OFF_AU) + (size_t)(rowb + rr - T_PROMPT) * 1024; f32x4 a = ((const f32x4*)zs)[lane + 64 * j];
#pragma unroll
                    for (int k = 1; k < 11; ++k) a += ((const f32x4*)(zs + (size_t)k * 512 * 1024))[lane + 64 * j];
                    v[rr][j] = a; } }
#pragma unroll
        for (int rr = 0; rr < 4; ++rr) { float sm = 0.f;
#pragma unroll
            for (int j = 0; j < 4; ++j) sm += (v[rr][j][0] + v[rr][j][1]) + (v[rr][j][2] + v[rr][j][3]);
            const float mean = wave_sum(sm) * (1.0f / 1024.0f); float s2 = 0.f;
#pragma unroll
            for (int j = 0; j < 4; ++j) { v[rr][j] = v[rr][j] - mean; s2 += (v[rr][j][0] * v[rr][j][0] + v[rr][j][1] * v[rr][j][1]) + (v[rr][j][2] * v[rr][j][2] + v[rr][j][3] * v[rr][j][3]); }
            rstd[rr] = 1.0f / sqrtf(wave_sum(s2) * (1.0f / 1024.0f) + LN_EPS); }
#pragma unroll
        for (int j = 0; j < 4; ++j) { const int c = 4 * (lane + 64 * j);
            const f32x4 gv = *(const f32x4*)(p.ln2_g + c), bv = *(const f32x4*)(p.ln2_b + c);
#pragma unroll
            for (int rr = 0; rr < 4; ++rr) if (!dry) ((f32x4*)(p.out + (size_t)(rowb + rr) * 1024))[lane + 64 * j] = v[rr][j] * rstd[rr] * gv + bv; }
    }
}

#define XB_TMO      128
#define XB_XCNT(j)  (256  + 64 * (j))
#define XB_XSUB(j)  (1280 + 64 * (j))
#define XB_XGEN(j)  (2304 + 64 * (j))
#define XB_TOP      3328
#define XB_TOPGEN   3392
#define XCD_BAR_WORDS 3456
#define XB_SPIN_CAP (1u << 22)
__device__ __forceinline__ unsigned xb_ld(unsigned* p)              { return __hip_atomic_load(p, __ATOMIC_RELAXED, __HIP_MEMORY_SCOPE_AGENT); }
__device__ __forceinline__ unsigned xb_add(unsigned* p, unsigned v) { return __hip_atomic_fetch_add(p, v, __ATOMIC_RELAXED, __HIP_MEMORY_SCOPE_AGENT); }
__device__ __forceinline__ unsigned xb_xcc_id() { return (unsigned)__builtin_amdgcn_s_getreg((3 << 11) | 20) & 0xFu; }
#define XB_SPIN(cond, bar) do { unsigned _sp = 0; while (cond) { __builtin_amdgcn_s_sleep(1); \
    if ((++_sp & 255u) == 0u) { if (xb_ld(&(bar)[XB_TMO])) break; if (_sp > XB_SPIN_CAP) { atomicAdd(&(bar)[XB_TMO], 1u); break; } } } } while (0)
struct XcdBarrier { unsigned* bar; unsigned x; volatile LAS unsigned* st; };
__device__ __forceinline__ XcdBarrier xcd_barrier_post(unsigned* bar, volatile LAS unsigned* st) {
    XcdBarrier b; b.bar = bar; b.x = xb_xcc_id(); b.st = st;
    if (threadIdx.x == 0) (void)xb_add(&bar[XB_XCNT(b.x)], 1u);
    return b;
}
__device__ __forceinline__ void xcd_barrier_complete(unsigned* bar, unsigned x, unsigned& nloc, unsigned& nx) {
    const unsigned G = gridDim.x * gridDim.y * gridDim.z;
    unsigned sum, cnt, mine, sp = 0u;
    for (;;) {
        sum = 0u; cnt = 0u; mine = 0u;
#pragma unroll
        for (unsigned j = 0; j < 16; ++j) { const unsigned c = xb_ld(&bar[XB_XCNT(j)]); sum += c; cnt += (c > 0u) ? 1u : 0u; mine = (j == x) ? c : mine; }
        if (sum == G) break;
        __builtin_amdgcn_s_sleep(1);
        if ((++sp & 255u) == 0u) { if (xb_ld(&bar[XB_TMO])) break; if (sp > XB_SPIN_CAP) { atomicAdd(&bar[XB_TMO], 1u); break; } }
    }
    nloc = mine > 0u ? mine : 1u; nx = cnt > 0u ? cnt : 1u;
}
__device__ __forceinline__ void xcd_barrier(const XcdBarrier& b) {
    asm volatile("s_waitcnt vmcnt(0)" ::: "memory");
    __syncthreads();
    if (threadIdx.x == 0) {
        unsigned* bar = b.bar;
        __builtin_amdgcn_s_waitcnt(0);
        unsigned nloc = b.st[0], nx = b.st[1];
        if (nloc == 0u) { xcd_barrier_complete(bar, b.x, nloc, nx); b.st[0] = nloc; b.st[1] = nx; }
        const unsigned old = xb_add(&bar[XB_XSUB(b.x)], 1u);
        const unsigned gen = old / nloc;
        if (old + 1u == (gen + 1u) * nloc) {
            __builtin_amdgcn_fence(__ATOMIC_RELEASE, "agent");
            asm volatile("s_waitcnt vmcnt(0)" ::: "memory");
            const unsigned og = xb_add(&bar[XB_TOP], 1u);
            const unsigned tg = og / nx;
            if (og + 1u == (tg + 1u) * nx) xb_add(&bar[XB_TOPGEN], 1u);
            else XB_SPIN(xb_ld(&bar[XB_TOPGEN]) == tg, bar);
            __builtin_amdgcn_fence(__ATOMIC_ACQUIRE, "agent");
            xb_add(&bar[XB_XGEN(b.x)], 1u);
            asm volatile("s_waitcnt vmcnt(0)" ::: "memory");
        } else {
            XB_SPIN(xb_ld(&bar[XB_XGEN(b.x)]) == gen, bar);
            __builtin_amdgcn_fence(__ATOMIC_ACQUIRE, "agent");
            asm volatile("s_waitcnt vmcnt(0)" ::: "memory");
        }
    }
    __syncthreads();
}

constexpr int NPHASES = 14;
#ifndef REP_MASK
#define REP_MASK 0
#endif
#ifndef PH_MASK
#define PH_MASK 0xFFFF
#endif
#define PH_ON(k) ((PH_MASK >> (k)) & 1)
__global__ void __launch_bounds__(512, 2) mega_fwd(Params p) {
    extern __shared__ __attribute__((aligned(16))) unsigned char shm[];
    LAS unsigned char* lds = (LAS unsigned char*)shm;
    cg::grid_group grid = cg::this_grid();
    unsigned char* ws = p.ws;
    if (threadIdx.x < 4) ((LAS unsigned*)(lds + LDS_BAR_OFF))[threadIdx.x] = 0u;
    __syncthreads();
    const XcdBarrier xbar = xcd_barrier_post((unsigned*)(ws + OFF_BAR), (volatile LAS unsigned*)(lds + LDS_BAR_OFF));
    const int G = gridDim.x, c = blockIdx.x;
    const int lo = p.ph_lo, hi = p.ph_hi;
#define PH_SYNC(k) do { if ((k) + 1 < hi) { if (lo > 1000) grid.sync(); else xcd_barrier(xbar); } } while (0)
    if (lo <= 0 && 0 < hi) { if constexpr (PH_ON(0)) { for (int rep = (p.rep_mask >> 0) & 1; rep >= 0; --rep) phase0(p, lds); } PH_SYNC(0); }
    if (lo <= 1 && 1 < hi) { if constexpr (PH_ON(1)) { for (int rep = (p.rep_mask >> 1) & 1; rep >= 0; --rep) phase1(p, lds); } PH_SYNC(1); }
    if (lo <= 2 && 2 < hi) { if constexpr (PH_ON(2)) { { pg8::Gemm g{(const bf16_t*)p.out, (const bf16_t*)(ws + OFF_WIN), T_ALL, 17 * 256, 1024, 1024}; pg8::StaticOrder S; S.init(g.M, g.N, G, c, g.K);
            EpiIn<0> E{(bf16_t*)(ws + OFF_Q), (bf16_t*)(ws + OFF_K), (bf16_t*)(ws + OFF_ACAT), nullptr, nullptr, nullptr, nullptr, (const float*)(ws + OFF_ROT)};
            S.total = S.nwg << ((p.rep_mask >> 2) & 1); pg8::gemm_phase(lds, g, S, E); } } PH_SYNC(2); }
    if (lo <= 3 && 3 < hi) { if constexpr (PH_ON(3)) { for (int rep = (p.rep_mask >> 3) & 1; rep >= 0; --rep) phase_retention(p, lds, rep > 0); } PH_SYNC(3); }
    if (lo <= 4 && 4 < hi) { if constexpr (PH_ON(4)) { { pg8::Gemm g{(const bf16_t*)p.out, (const bf16_t*)(ws + OFF_WIN) + (size_t)17 * 256 * 1024, T_ALL, 19 * 256, 1024, 1024}; pg8::StaticOrder S; S.init(g.M, g.N, G, c, g.K);
            EpiIn<1> E{nullptr, nullptr, (bf16_t*)(ws + OFF_ACAT), (bf16_t*)(ws + OFF_G), (bf16_t*)(ws + OFF_U), (bf16_t*)(ws + OFF_RS_S), (bf16_t*)(ws + OFF_RS_S) + 512 * 1024, nullptr};
            S.add_extra(128, 2, 19, 8); pg8::gemm_phase(lds, g, S, E); } } PH_SYNC(4); }
    if (lo <= 5 && 5 < hi) { if constexpr (PH_ON(5)) { for (int rep = (p.rep_mask >> 5) & 1; rep >= 0; --rep) phase_mix_elem(p, rep > 0); } PH_SYNC(5); }
    if (lo <= 6 && 6 < hi) { if constexpr (PH_ON(6)) { { pg8::Gemm g{(const bf16_t*)p.out, (const bf16_t*)(ws + OFF_WIN) + (size_t)36 * 256 * 1024, T_PROMPT, 8 * 256, 1024, 1024}; pg8::StaticOrder S; S.init(g.M, g.N, G, c, g.K);
            EpiIn<2> E{nullptr, nullptr, nullptr, nullptr, nullptr, (bf16_t*)(ws + OFF_R), (bf16_t*)(ws + OFF_SC), nullptr};
            S.total = S.nwg << ((p.rep_mask >> 6) & 1); pg8::gemm_phase(lds, g, S, E); } } PH_SYNC(6); }
    if (lo <= 7 && 7 < hi) { if constexpr (PH_ON(7)) { { pg8::Gemm g{(const bf16_t*)(ws + OFF_ACAT), (const bf16_t*)(ws + OFF_WCAT), T_ALL, 1024, 3072, 3072}; pg8::StaticOrder S; S.init(g.M, g.N, G, c, g.K);
            EpiMerged E{(const bf16_t*)(ws + OFF_R), (const bf16_t*)(ws + OFF_SC), (bf16_t*)(ws + OFF_MERGED), (float*)(ws + OFF_MS32), (const bf16_t*)(ws + OFF_RS_S), (const bf16_t*)(ws + OFF_RS_S) + 512 * 1024};
            S.split_tail(2, 4); pg8::gemm_phase(lds, g, S, E); }
            xcd_barrier(xbar);
            { const float* ms = (const float*)(ws + OFF_MS32); bf16_t* mo = (bf16_t*)(ws + OFF_MERGED) + (size_t)T_PROMPT * 1024;
              for (int i = blockIdx.x * 512 + threadIdx.x; i < 512 * 1024 / 4; i += gridDim.x * 512) { f32x4 v = ((const f32x4*)ms)[i];
#pragma unroll
                  for (int k = 1; k < 12; ++k) v += ((const f32x4*)(ms + (size_t)k * 512 * 1024))[i];
                  u32x2 w; w.x = cvt_pk_bf16(v[0], v[1]); w.y = cvt_pk_bf16(v[2], v[3]); ((u32x2*)mo)[i] = w; } } } PH_SYNC(7); }
    if (lo <= 8 && 8 < hi) { if constexpr (PH_ON(8)) { { pg8::Gemm g{(const bf16_t*)(ws + OFF_MERGED), (const bf16_t*)(ws + OFF_WOUT), T_ALL, 1024, 1024, 1024}; pg8::StaticOrder S; S.init(g.M, g.N, G, c, g.K);
            EpiOut E{p.x_prompt, p.x_sample, (const float*)(ws + OFF_LNST), p.ln_in_g, p.ln_in_b, p.b_out, (const float*)(ws + OFF_MOD), p.out, (float*)(ws + OFF_MS32)};
            S.split_tail(2, 4); pg8::gemm_phase(lds, g, S, E); } } PH_SYNC(8); }
    if (lo <= 9 && 9 < hi) { if constexpr (PH_ON(9)) { for (int rep = (p.rep_mask >> 9) & 1; rep >= 0; --rep) phase_ln1(p, rep > 0); } PH_SYNC(9); }
    if (lo <= 10 && 10 < hi) { if constexpr (PH_ON(10)) { { pg8::Gemm g{(const bf16_t*)p.out, (const bf16_t*)(ws + OFF_WUP), T_ALL, 5632, 1024, 2048}; pg8::StaticOrder S; S.init(g.M, g.N, G, c, g.K);
            EpiUp E{(bf16_t*)(ws + OFF_AU), (bf16_t*)(ws + OFF_GBF), p.out};
            S.split_tail(2, 4); pg8::gemm_phase(lds, g, S, E); } } PH_SYNC(10); }
    if (lo <= 11 && 11 < hi) { if constexpr (PH_ON(11)) { for (int rep = (p.rep_mask >> 11) & 1; rep >= 0; --rep) phase_ffn_elem(p, rep > 0); } PH_SYNC(11); }
    if (lo <= 12 && 12 < hi) { if constexpr (PH_ON(12)) { { pg8::Gemm g{(const bf16_t*)(ws + OFF_GBF), (const bf16_t*)(ws + OFF_WDOWN), T_ALL, 1024, DFF, DFF}; pg8::StaticOrder S; S.init(g.M, g.N, G, c, g.K);
            EpiDown E{(const bf16_t*)(ws + OFF_X1), p.b_down, (const float*)(ws + OFF_MOD), p.out, (float*)(ws + OFF_AU)};
            S.split_tail(2, 4); pg8::gemm_phase(lds, g, S, E); } } PH_SYNC(12); }
    if (lo <= 13 && 13 < hi) { if constexpr (PH_ON(13)) { for (int rep = (p.rep_mask >> 13) & 1; rep >= 0; --rep) phase_ln2(p, rep > 0); } PH_SYNC(13); }
}

extern "C" void kernel_launch(void* const* d_in, const int* in_sizes, int n_in, void* d_out, int out_size, void* d_ws, size_t ws_size, hipStream_t stream) {
    static int grid = 0;
    if (grid == 0) {
        if (n_in != 27 || ws_size < WS_NEED) { fprintf(stderr, "kernel_launch: n_in %d ws %zu (need %zu)\n", n_in, ws_size, (size_t)WS_NEED); grid = -1; return; }
        int dev = 0, cus = 0, per_cu = 0;
        hipGetDevice(&dev); hipDeviceGetAttribute(&cus, hipDeviceAttributeMultiprocessorCount, dev);
        if (hipFuncSetAttribute((const void*)mega_fwd, hipFuncAttributeMaxDynamicSharedMemorySize, LDS_BYTES) != hipSuccess) { fprintf(stderr, "hipFuncSetAttribute failed\n"); grid = -1; return; }
        if (hipOccupancyMaxActiveBlocksPerMultiprocessor(&per_cu, (const void*)mega_fwd, 512, LDS_BYTES) != hipSuccess || per_cu < 1) { fprintf(stderr, "occupancy query: %d\n", per_cu); per_cu = 1; }
        (void)hipGetLastError();
        grid = cus * 1;
    }
    if (grid < 0) return;
    Params p{};
    const float** f = (const float**)&p;
    for (int i = 0; i < 27; ++i) f[i] = (const float*)d_in[i];
    p.out = (float*)d_out; p.ws = (unsigned char*)d_ws; p.ph_lo = 0; p.ph_hi = NPHASES; p.rep_mask = REP_MASK; p.pad = 0;
    if (hipMemsetAsync((char*)d_ws + OFF_BAR, 0, XCD_BAR_WORDS * 4, stream) != hipSuccess) { fprintf(stderr, "memset failed\n"); return; }
    void* args[] = {&p};
    hipError_t e = hipLaunchCooperativeKernel((const void*)mega_fwd, dim3(grid), dim3(512), args, LDS_BYTES, stream);
    if (e != hipSuccess) fprintf(stderr, "cooperative launch failed: %s (grid %d)\n", hipGetErrorString(e), grid);
}
```

```cpp
#include <hip/hip_runtime.h>
#include <hip/hip_cooperative_groups.h>
#include <cstdio>
#include <cstdint>
namespace cg = cooperative_groups;

#define LAS __attribute__((address_space(3)))
typedef unsigned short bf16_t;
typedef short bf16x8 __attribute__((ext_vector_type(8)));
typedef float f32x4 __attribute__((ext_vector_type(4)));
typedef float f32x2 __attribute__((ext_vector_type(2)));
typedef unsigned u32x4 __attribute__((ext_vector_type(4)));
typedef unsigned u32x2 __attribute__((ext_vector_type(2)));

constexpr int T_ALL = 33280, T_PROMPT = 32768, DM = 1024, DFF = 2816;
constexpr float LN_EPS = 1e-5f;
constexpr float ALPHA = 1.189207115002721f;
constexpr size_t S1 = (size_t)T_ALL * 1024 * 2;
constexpr size_t OFF_WIN = 0, OFF_WCAT = 23068672, OFF_WOUT = 29360128, OFF_WUP = 31457280, OFF_WDOWN = 42991616;
constexpr size_t OFF_MODP = 62914560  , OFF_MOD = 55050240, OFF_ROT = 55836672, OFF_LNST = 57966592, OFF_RST = 58232832;
constexpr size_t OFF_ACT = 62914560;
constexpr size_t OFF_ACAT = OFF_ACT, OFF_Q = OFF_ACT + 3 * S1, OFF_K = OFF_ACT + 4 * S1, OFF_G = OFF_ACT + 3 * S1, OFF_R = OFF_ACT + 3 * S1, OFF_SC = OFF_ACT + 4 * S1;
constexpr size_t OFF_U = OFF_ACT + 5 * S1, OFF_MERGED = OFF_ACT + 5 * S1, OFF_MS32 = OFF_ACT + 6 * S1, OFF_RS_S = OFF_MS32 + (size_t)12 * 512 * 1024 * 4;
constexpr size_t OFF_X1 = OFF_ACT, OFF_AU = OFF_ACT + S1, OFF_GBF = OFF_AU + (size_t)T_ALL * DFF * 2;
constexpr size_t WS_NEED = OFF_GBF + (size_t)T_ALL * DFF * 2;
constexpr size_t OUT_YS = 33554432, OUT_RETP = 34078720, OUT_CONVP = 42467328, OUT_FFNP = 42500096, OUT_RETS = 42590208, OUT_CONVS = 50978816, OUT_FFNS = 51011584;
constexpr int LDS_BAR_OFF = 136192, LDS_BYTES = 136192 + 16;
constexpr size_t OFF_BAR = 62492672;

struct Params {
    const float *x_prompt, *x_sample, *c_prompt, *c_sample, *state_ret, *state_conv, *state_ffn;
    const float *ln_in_g, *ln_in_b, *w_mod, *b_mod, *w_in, *w_o_ret, *conv_w, *conv_b, *w_o_conv, *w_out, *b_out;
    const float *ln1_g, *ln1_b, *w_up, *ffn_conv_w, *ffn_conv_b, *w_down, *b_down, *ln2_g, *ln2_b;
    float* out; unsigned char* ws; int ph_lo, ph_hi, rep_mask, pad;
};

__device__ __forceinline__ unsigned cvt_pk_bf16(float lo, float hi) { unsigned r; asm volatile("v_cvt_pk_bf16_f32 %0, %1, %2" : "=v"(r) : "v"(lo), "v"(hi)); return r; }
__device__ __forceinline__ float bf_lo(unsigned w) { return __uint_as_float(w << 16); }
__device__ __forceinline__ float bf_hi(unsigned w) { return __uint_as_float(w & 0xffff0000u); }
__device__ __forceinline__ float wave_sum(float v) {
#pragma unroll
    for (int o = 1; o < 64; o <<= 1) v += __shfl_xor(v, o);
    return v;
}
__device__ __forceinline__ int row_seq(int row) { return row < T_PROMPT ? (row >> 11) : 16 + ((row - T_PROMPT) >> 5); }
__device__ __forceinline__ int row_pos(int row) { return row < T_PROMPT ? (row & 2047) : 2048 + ((row - T_PROMPT) & 31); }
__device__ __forceinline__ float sigmoidf_(float x) { return 1.0f / (1.0f + __expf(-x)); }
__device__ __forceinline__ float gelu_f(float v) {
    const float av = fabsf(v), t = __builtin_amdgcn_rcpf(av * 0.2316418882f + 1.0f);
    float q = t * 0.5307027145f + (-0.7265760135f); q = q * t + 0.7107068705f; q = q * t + (-0.142248368f); q = q * t + 0.127414796f; q = q * t;
    const float e = __builtin_amdgcn_exp2f((v * v) * (-0.72134752044f));
    const float m = v * (q * e);
    return v < 0.f ? m : v - m;
}

namespace pg8 {
constexpr int BM = 256, BK = 64, HALF = 128, HTB = HALF * BK * 2, STAGE_BYTES = 8 * HTB, NXCD = 8, WGM = 4;
__host__ __device__ __forceinline__ int lds_byte(int r, int c) { const int st = (r >> 4) * 2 + (c >> 5), rr = r & 15, cc = c & 31, ob = rr * 64 + cc * 2; return st * 1024 + (ob ^ (((ob >> 9) & 1) << 5)); }
__host__ __device__ __forceinline__ void stage_rc(int b, int& R, int& C) { const int st = b / 1024, sb = b % 1024, swz = sb ^ (((sb >> 9) & 1) << 5); R = (st >> 1) * 16 + swz / 64; C = (st & 1) * 32 + (swz % 64) / 2; }
__host__ __device__ __forceinline__ int perm32(int rho) { const int n = rho >> 4, i = rho & 15; return 8 * (i >> 2) + 4 * n + (i & 3); }
struct Unit { int pm, pn, kt0, nkt; };
struct Gemm { const bf16_t* A; const bf16_t* Bt; int M, N, K, lda; };
struct StaticOrder {
    int nM, nN, nwg, G, c, total, ntf, nMs, npk, pkt, ex_pm0, ex_pn0, ex_nN, wgm;
    __device__ void init(int M, int N, int G_, int c_, int K) { wgm = WGM; nM = M / BM; nN = N / BM; nwg = nM * nN; G = G_; c = c_; total = nwg; ntf = K / BK; nMs = 0; npk = 1; pkt = ntf; ex_pm0 = 0; ex_pn0 = 0; ex_nN = 1; }
    __device__ void split_tail(int tail_tiles, int piece_kt) { nM -= tail_tiles; nMs = tail_tiles; nwg = nM * nN; pkt = piece_kt; npk = ntf / piece_kt; ex_pm0 = nM; ex_pn0 = 0; ex_nN = nN; total = nwg + nMs * nN * npk; }
    __device__ void add_extra(int pm0, int ntiles, int pn0, int nNe) { nMs = ntiles; ex_pm0 = pm0; ex_pn0 = pn0; ex_nN = nNe; npk = 1; pkt = ntf; total = nwg + ntiles * nNe; }
    __device__ bool next(int i, Unit& u) const {
        const long L = (long)i * G + c; if (L >= total) return false;
        if (nMs > 0 && L >= nwg) { const int sp = (int)L - nwg, un = sp / npk, kp = sp - un * npk; u.pm = ex_pm0 + un / ex_nN; u.pn = ex_pn0 + un % ex_nN; u.kt0 = kp * pkt; u.nkt = pkt; return true; }
        int wgid = (int)(L >= nwg ? L - nwg : L); { const int q = nwg / NXCD, r = nwg % NXCD, xcd = wgid % NXCD, off = wgid / NXCD; wgid = (xcd < r ? xcd * (q + 1) : r * (q + 1) + (xcd - r) * q) + off; }
        const int nig = wgm * nN, gid = wgid / nig, fm = gid * wgm, gsz = (nM - fm) < wgm ? (nM - fm) : wgm;
        u.pm = fm + ((wgid % nig) % gsz); u.pn = (wgid % nig) / gsz; u.kt0 = 0; u.nkt = ntf; return true;
    }
};
template <class Epi>
__device__ __forceinline__ void gemm_phase(LAS unsigned char* lds, const Gemm g, const StaticOrder& S, const Epi& E) {
    const int tid = threadIdx.x, wid = __builtin_amdgcn_readfirstlane(tid >> 6), lane = tid & 63, wr = wid >> 2, wc = wid & 3, fr = lane & 15, fq = lane >> 4;
    const int K = g.K, ntf = K / BK;
    unsigned voffA[2], voffB[2];
#pragma unroll
    for (int i = 0; i < 2; ++i) { int R, C; stage_rc(tid * 16 + i * 8192, R, C); const int Rb = Epi::PERM ? ((R & ~31) + perm32(R & 31)) : R;
        voffA[i] = (unsigned)(R * g.lda + C) * 2u; voffB[i] = (unsigned)(Rb * K + C) * 2u; }
    const size_t kstep = (size_t)(BK * 2);
    const size_t hstepA = (size_t)HALF * g.lda * 2, hstepB = (size_t)HALF * K * 2;
    const size_t tstepA = 2 * hstepA, tstepB = 2 * hstepB;
    const unsigned ldsw = (unsigned)wid * 1024u;
    const int aoff = lds_byte(wr * 64 + fr, fq * 8), boff = lds_byte(wc * 32 + fr, fq * 8);
#define PG8_SA(b, h) (((b) * 2 + (h)) * HTB)
#define PG8_SB(b, h) ((4 + (b) * 2 + (h)) * HTB)
#define PG8_STAGE(bufoff, gbase, voff) do { _Pragma("unroll") for (int _i = 0; _i < 2; ++_i) \
        __builtin_amdgcn_global_load_lds((const unsigned*)((const char*)(gbase) + (voff)[_i]), (LAS unsigned*)(lds + (bufoff) + ldsw + _i * 8192), 16, 0, 0); } while (0)
#define PG8_LDA(dst, b, h) do { _Pragma("unroll") for (int m = 0; m < 4; ++m) _Pragma("unroll") for (int k = 0; k < 2; ++k) dst[m][k] = *(const LAS bf16x8*)(lds + PG8_SA(b, h) + aoff + m * 2048 + k * 1024); } while (0)
#define PG8_LDB(dst, b, h) do { _Pragma("unroll") for (int n = 0; n < 2; ++n) _Pragma("unroll") for (int k = 0; k < 2; ++k) dst[n][k] = *(const LAS bf16x8*)(lds + PG8_SB(b, h) + boff + n * 2048 + k * 1024); } while (0)
#define PG8_MMA(ai, bj, At, Bt) do { __builtin_amdgcn_s_setprio(1); _Pragma("unroll") for (int m = 0; m < 4; ++m) _Pragma("unroll") for (int n = 0; n < 2; ++n) _Pragma("unroll") for (int k = 0; k < 2; ++k) \
        acc[ai][bj][m][n] = __builtin_amdgcn_mfma_f32_16x16x32_bf16(Bt[n][k], At[m][k], acc[ai][bj][m][n], 0, 0, 0); __builtin_amdgcn_s_setprio(0); } while (0)
#define PG8_WAIT_V(n) asm volatile("s_waitcnt vmcnt(" #n ")" ::: "memory")
#define PG8_WAIT_L(n) asm volatile("s_waitcnt lgkmcnt(" #n ")" ::: "memory")
#define PG8_BAR __builtin_amdgcn_s_barrier()
#define PG8_SCHED __builtin_amdgcn_sched_barrier(0)
    Unit cur, nxt; int ui = 0;
    if (!S.next(0, cur)) return;
    f32x4 acc[2][2][4][2];
#pragma unroll
    for (int a = 0; a < 2; ++a)
#pragma unroll
        for (int b = 0; b < 2; ++b)
#pragma unroll
            for (int m = 0; m < 4; ++m)
#pragma unroll
                for (int n = 0; n < 2; ++n) acc[a][b][m][n] = (f32x4){0.f, 0.f, 0.f, 0.f};
    bf16x8 At[4][2], B0[2][2], B1[2][2];
    const char* cA = (const char*)g.A + (size_t)cur.pm * tstepA + (size_t)cur.kt0 * kstep; const char* cB = (const char*)g.Bt + (size_t)cur.pn * tstepB + (size_t)cur.kt0 * kstep;
    PG8_STAGE(PG8_SB(0, 0), cB, voffB); PG8_STAGE(PG8_SB(0, 1), cB + hstepB, voffB); PG8_STAGE(PG8_SA(0, 0), cA, voffA); PG8_STAGE(PG8_SA(0, 1), cA + hstepA, voffA);
    if (wr == 1) PG8_BAR;
    PG8_WAIT_V(2); PG8_BAR;
    PG8_STAGE(PG8_SB(1, 0), cB + kstep, voffB); PG8_STAGE(PG8_SA(1, 0), cA + kstep, voffA); PG8_STAGE(PG8_SB(1, 1), cB + hstepB + kstep, voffB);
    PG8_WAIT_V(6); PG8_BAR;
    for (;;) {
        const bool has_next = S.next(ui + 1, nxt);
        const char* nA = has_next ? (const char*)g.A + (size_t)nxt.pm * tstepA + (size_t)nxt.kt0 * kstep : cA; const char* nB = has_next ? (const char*)g.Bt + (size_t)nxt.pn * tstepB + (size_t)nxt.kt0 * kstep : cB;
        const int nt = cur.nkt;
        for (int t = 0; t < nt; t += 2) {
            const bool last = (t == nt - 2);
            const char* a1 = cA + (size_t)(t + 1) * kstep;
            const char* a2 = last ? nA : cA + (size_t)(t + 2) * kstep; const char* b2 = last ? nB : cB + (size_t)(t + 2) * kstep;
            const char* a3 = a2 + kstep; const char* b3 = b2 + kstep;
            if constexpr (Epi::HOOK_T > 0) { if (t == Epi::HOOK_T && nt == ntf) { E.mid(acc, cur, wr, wc, fr, fq); PG8_SCHED; } }
            PG8_LDB(B0, 0, 0); PG8_LDB(B1, 0, 1); PG8_SCHED; PG8_LDA(At, 0, 0); PG8_STAGE(PG8_SA(1, 1), a1 + hstepA, voffA);
            PG8_WAIT_V(8); PG8_WAIT_L(0); PG8_BAR; PG8_MMA(0, 0, At, B0); PG8_MMA(0, 1, At, B1); PG8_BAR; PG8_SCHED;
            PG8_LDA(At, 0, 1); PG8_STAGE(PG8_SB(0, 0), b2, voffB); PG8_STAGE(PG8_SB(0, 1), b2 + hstepB, voffB); PG8_STAGE(PG8_SA(0, 0), a2, voffA);
            PG8_WAIT_V(8); PG8_WAIT_L(0); PG8_BAR; PG8_MMA(1, 0, At, B0); PG8_MMA(1, 1, At, B1); PG8_BAR; PG8_SCHED;
            PG8_LDB(B0, 1, 0); PG8_LDB(B1, 1, 1); PG8_SCHED; PG8_LDA(At, 1, 0); PG8_STAGE(PG8_SA(0, 1), a2 + hstepA, voffA);
            PG8_WAIT_V(8); PG8_WAIT_L(0); PG8_BAR; PG8_MMA(0, 0, At, B0); PG8_MMA(0, 1, At, B1); PG8_BAR; PG8_SCHED;
            PG8_LDA(At, 1, 1); PG8_STAGE(PG8_SB(1, 0), b3, voffB); PG8_STAGE(PG8_SB(1, 1), b3 + hstepB, voffB); PG8_STAGE(PG8_SA(1, 0), a3, voffA);
            PG8_WAIT_V(8); PG8_WAIT_L(0); PG8_BAR; PG8_MMA(1, 0, At, B0); PG8_MMA(1, 1, At, B1); PG8_BAR; PG8_SCHED;
        }
        if (wr == 0) PG8_BAR;
        E(acc, cur, wr, wc, fr, fq);
        if (!has_next) break;
#pragma unroll
        for (int a = 0; a < 2; ++a)
#pragma unroll
            for (int b = 0; b < 2; ++b)
#pragma unroll
                for (int m = 0; m < 4; ++m)
#pragma unroll
                    for (int n = 0; n < 2; ++n) acc[a][b][m][n] = (f32x4){0.f, 0.f, 0.f, 0.f};
        cur = nxt; cA = nA; cB = nB; ++ui;
        if (wr == 1) PG8_BAR;
    }
    PG8_WAIT_V(0);
    PG8_BAR;
#undef PG8_SA
#undef PG8_SB
#undef PG8_STAGE
#undef PG8_LDA
#undef PG8_LDB
#undef PG8_MMA
#undef PG8_WAIT_V
#undef PG8_WAIT_L
#undef PG8_BAR
#undef PG8_SCHED
}
}
using pg8::Unit;

__device__ __forceinline__ void store8(bf16_t* p, const f32x4 v0, const f32x4 v1) {
    u32x4 w; w.x = cvt_pk_bf16(v0[0], v0[1]); w.y = cvt_pk_bf16(v0[2], v0[3]); w.z = cvt_pk_bf16(v1[0], v1[1]); w.w = cvt_pk_bf16(v1[2], v1[3]);
    *(u32x4*)p = w;
}
__device__ __forceinline__ void rs_store(const f32x4 (&acc)[2][2][4][2], int row0, int col, bf16_t* R, bf16_t* SC) {
#pragma unroll
    for (int ai = 0; ai < 2; ++ai)
#pragma unroll
        for (int m = 0; m < 4; ++m) { const int row = row0 + ai * 128 + m * 16;
            f32x4 r[2], s[2];
#pragma unroll
            for (int n = 0; n < 2; ++n)
#pragma unroll
                for (int j = 0; j < 4; ++j) { const float ea = __builtin_amdgcn_exp2f(acc[ai][0][m][n][j] * -1.4426950408889634f), eb = __builtin_amdgcn_exp2f(acc[ai][1][m][n][j] * -1.4426950408889634f);
                    s[n][j] = __builtin_amdgcn_rcpf(1.0f + eb); r[n][j] = (1.0f + eb) * __builtin_amdgcn_rcpf(1.0f + ea); }
            store8(R + (size_t)row * 1024 + col, r[0], r[1]); store8(SC + (size_t)row * 1024 + col, s[0], s[1]); }
}
template <int SUB> struct EpiIn {
    static constexpr bool PERM = true; static constexpr int HOOK_T = -1;
    bf16_t *Q, *Kb, *ACAT, *G, *U, *R, *SC; const float* rot;
    __device__ __forceinline__ void mid(f32x4 (&)[2][2][4][2], const Unit&, int, int, int, int) const {}
    __device__ __forceinline__ void operator()(const f32x4 (&acc)[2][2][4][2], const Unit& u, int wr, int wc, int fr, int fq) const {
        asm volatile("" : "+v"(fr), "+v"(fq));
        const int row0 = u.pm * 256 + wr * 64 + fr; const int cl = wc * 32 + 8 * fq;
        if constexpr (SUB == 0) {
            if (u.pn < 8) {
                bf16_t* base = (u.pn < 4) ? Q : Kb; const float sc = (u.pn < 4) ? 1.0f : 0.0625f; const int colt = (u.pn & 3) * 256;
#pragma unroll
                for (int ai = 0; ai < 2; ++ai)
#pragma unroll
                    for (int m = 0; m < 4; ++m) { const int row = row0 + ai * 128 + m * 16; const int pos = row_pos(row);
#pragma unroll
                        for (int bj = 0; bj < 2; ++bj) { const int c0 = bj * 128 + cl;
                            const f32x4* rp = (const f32x4*)(rot + ((size_t)pos * 128 + (c0 >> 1)) * 2);
                            const f32x4 t0 = rp[0], t1 = rp[1];
                            const f32x4 a = acc[ai][bj][m][0], b = acc[ai][bj][m][1];
                            f32x4 o0, o1;
                            o0[0] = (a[0] * t0[0] - a[1] * t0[1]) * sc; o0[1] = (a[0] * t0[1] + a[1] * t0[0]) * sc;
                            o0[2] = (a[2] * t0[2] - a[3] * t0[3]) * sc; o0[3] = (a[2] * t0[3] + a[3] * t0[2]) * sc;
                            o1[0] = (b[0] * t1[0] - b[1] * t1[1]) * sc; o1[1] = (b[0] * t1[1] + b[1] * t1[0]) * sc;
                            o1[2] = (b[2] * t1[2] - b[3] * t1[3]) * sc; o1[3] = (b[2] * t1[3] + b[3] * t1[2]) * sc;
                            store8(base + (size_t)row * 1024 + colt + c0, o0, o1); } }
            } else {
                const int colt = (u.pn - 8) * 256;
#pragma unroll
                for (int ai = 0; ai < 2; ++ai)
#pragma unroll
                    for (int m = 0; m < 4; ++m) { const int row = row0 + ai * 128 + m * 16;
#pragma unroll
                        for (int bj = 0; bj < 2; ++bj) store8(ACAT + (size_t)row * 3072 + colt + bj * 128 + cl, acc[ai][bj][m][0], acc[ai][bj][m][1]); }
            }
        } else if constexpr (SUB == 1) {
            if (u.pn >= 19) {
                rs_store(acc, row0 - T_PROMPT, (u.pn - 19) * 128 + cl, R, SC);
            } else if (u.pn < 11) {
                bf16_t* base; int ld;
                if (u.pn < 8) { base = G + u.pn * 256; ld = 2048; } else { base = ACAT + 2048 + (u.pn - 7) * 256; ld = 3072; }
#pragma unroll
                for (int ai = 0; ai < 2; ++ai)
#pragma unroll
                    for (int m = 0; m < 4; ++m) { const int row = row0 + ai * 128 + m * 16;
#pragma unroll
                        for (int bj = 0; bj < 2; ++bj) store8(base + (size_t)row * ld + bj * 128 + cl, acc[ai][bj][m][0], acc[ai][bj][m][1]); }
            } else {
                const int colt = (u.pn - 11) * 128;
#pragma unroll
                for (int ai = 0; ai < 2; ++ai)
#pragma unroll
                    for (int m = 0; m < 4; ++m) { const int row = row0 + ai * 128 + m * 16;
                        store8(U + (size_t)row * 1024 + colt + cl, acc[ai][0][m][0] * acc[ai][1][m][0], acc[ai][0][m][1] * acc[ai][1][m][1]); }
            }
        } else {
            rs_store(acc, row0, u.pn * 128 + cl, R, SC);
        }
    }
};
struct EpiMerged {
    static constexpr bool PERM = true; static constexpr int HOOK_T = 32;
    const bf16_t *R, *SC; bf16_t* O; float* MS32; const bf16_t *Rs, *SCs;
    __device__ __forceinline__ void mid(f32x4 (&acc)[2][2][4][2], const Unit& u, int wr, int wc, int fr, int fq) const {
        asm volatile("" : "+v"(fr), "+v"(fq));
        const int row0 = u.pm * 256 + wr * 64 + fr, col0 = u.pn * 256 + wc * 32 + 8 * fq;
#pragma unroll
        for (int ai = 0; ai < 2; ++ai)
#pragma unroll
            for (int m = 0; m < 4; ++m) { const int row = row0 + ai * 128 + m * 16;
#pragma unroll
                for (int bj = 0; bj < 2; ++bj) { const u32x4 w = *(const u32x4*)(R + (size_t)row * 1024 + col0 + bj * 128);
                    acc[ai][bj][m][0] *= (f32x4){bf_lo(w.x), bf_hi(w.x), bf_lo(w.y), bf_hi(w.y)}; acc[ai][bj][m][1] *= (f32x4){bf_lo(w.z), bf_hi(w.z), bf_lo(w.w), bf_hi(w.w)}; }
                asm volatile("" ::: "memory"); }
    }
    __device__ __forceinline__ void operator()(const f32x4 (&acc)[2][2][4][2], const Unit& u, int wr, int wc, int fr, int fq) const {
        asm volatile("" : "+v"(fr), "+v"(fq));
        const int row0 = u.pm * 256 + wr * 64 + fr, col0 = u.pn * 256 + wc * 32 + 8 * fq;
        if (u.nkt != 48) {
            const bool ret = u.kt0 < 32;
#pragma unroll
            for (int ai = 0; ai < 2; ++ai)
#pragma unroll
                for (int m = 0; m < 4; ++m) { const int row = row0 + ai * 128 + m * 16;
#pragma unroll
                    for (int bj = 0; bj < 2; ++bj) { const u32x4 w = *(const u32x4*)(SCs + (size_t)(row - T_PROMPT) * 1024 + col0 + bj * 128);
                        u32x4 rw = (u32x4){0x3f803f80u, 0x3f803f80u, 0x3f803f80u, 0x3f803f80u};
                        if (ret) rw = *(const u32x4*)(Rs + (size_t)(row - T_PROMPT) * 1024 + col0 + bj * 128);
                        float* dst = MS32 + (size_t)(u.kt0 >> 2) * (512 * 1024) + (size_t)(row - T_PROMPT) * 1024 + col0 + bj * 128;
                        const f32x4 g0 = (f32x4){bf_lo(w.x) * bf_lo(rw.x), bf_hi(w.x) * bf_hi(rw.x), bf_lo(w.y) * bf_lo(rw.y), bf_hi(w.y) * bf_hi(rw.y)};
                        const f32x4 g1 = (f32x4){bf_lo(w.z) * bf_lo(rw.z), bf_hi(w.z) * bf_hi(rw.z), bf_lo(w.w) * bf_lo(rw.w), bf_hi(w.w) * bf_hi(rw.w)};
                        *(f32x4*)dst = acc[ai][bj][m][0] * g0; *(f32x4*)(dst + 4) = acc[ai][bj][m][1] * g1; }
                    asm volatile("" ::: "memory"); }
            return;
        }
#pragma unroll
        for (int ai = 0; ai < 2; ++ai)
#pragma unroll
            for (int m = 0; m < 4; ++m) { const int row = row0 + ai * 128 + m * 16;
#pragma unroll
                for (int bj = 0; bj < 2; ++bj) { const u32x4 w = *(const u32x4*)(SC + (size_t)row * 1024 + col0 + bj * 128);
                    store8(O + (size_t)row * 1024 + col0 + bj * 128, acc[ai][bj][m][0] * (f32x4){bf_lo(w.x), bf_hi(w.x), bf_lo(w.y), bf_hi(w.y)},
                           acc[ai][bj][m][1] * (f32x4){bf_lo(w.z), bf_hi(w.z), bf_lo(w.w), bf_hi(w.w)}); }
                asm volatile("" ::: "memory"); }
    }
};
struct EpiOut {
    static constexpr bool PERM = false; static constexpr int HOOK_T = -1;
    const float *x_prompt, *x_sample, *lnst, *ln_g, *ln_b, *bias, *mod; float* Z; float* ZS;
    __device__ __forceinline__ void mid(f32x4 (&)[2][2][4][2], const Unit&, int, int, int, int) const {}
    __device__ __forceinline__ void operator()(const f32x4 (&acc)[2][2][4][2], const Unit& u, int wr, int wc, int fr, int fq) const {
        asm volatile("" : "+v"(fr), "+v"(fq));
        const int row0 = u.pm * 256 + wr * 64 + fr, col0 = u.pn * 256 + wc * 32 + 4 * fq;
#pragma unroll
        for (int ai = 0; ai < 2; ++ai)
#pragma unroll
            for (int m = 0; m < 4; ++m) { const int row = row0 + ai * 128 + m * 16; const int s = row_seq(row);
                const float* xr = row < T_PROMPT ? x_prompt + (size_t)row * 1024 : x_sample + (size_t)(row - T_PROMPT) * 1024;
                const float mu = lnst[2 * row], rstd = lnst[2 * row + 1];
                const float* gt = mod + (size_t)s * 6144 + 2048;
#pragma unroll
                for (int bj = 0; bj < 2; ++bj)
#pragma unroll
                    for (int n = 0; n < 2; ++n) { const int c = col0 + bj * 128 + n * 16;
                        const f32x4 xv = *(const f32x4*)(xr + c), gv = *(const f32x4*)(ln_g + c), bv = *(const f32x4*)(ln_b + c), bo = *(const f32x4*)(bias + c), gg = *(const f32x4*)(gt + c);
                        const f32x4 xl = (xv - mu) * rstd * gv + bv;
                        if (u.nkt != 16) { f32x4 v = gg * acc[ai][bj][m][n]; if (u.kt0 == 0) v += xl * ALPHA + gg * bo;
                            *(f32x4*)(ZS + (size_t)(u.kt0 >> 2) * (512 * 1024) + (size_t)(row - T_PROMPT) * 1024 + c) = v; }
                        else *(f32x4*)(Z + (size_t)row * 1024 + c) = xl * ALPHA + gg * (acc[ai][bj][m][n] + bo); }
                asm volatile("" ::: "memory"); }
    }
};
__device__ __forceinline__ float* up_slab(float* ybase, int kp, int r, int pn) { const int sidx = (kp * 512 + r) * 22 + pn; return (float*)((char*)ybase + (size_t)(sidx >> 1) * 4096 + 2048 + (sidx & 1) * 1024); }
__device__ __forceinline__ u32x4 up_slab_sum8(const float* ybase, int r, int pn, int col) {
    f32x4 a = (f32x4){0.f, 0.f, 0.f, 0.f}, b = a;
#pragma unroll
    for (int kp = 0; kp < 4; ++kp) { const float* sp = up_slab((float*)ybase, kp, r, pn) + col; a += *(const f32x4*)sp; b += *(const f32x4*)(sp + 4); }
    u32x4 w; w.x = cvt_pk_bf16(a[0], a[1]); w.y = cvt_pk_bf16(a[2], a[3]); w.z = cvt_pk_bf16(b[0], b[1]); w.w = cvt_pk_bf16(b[2], b[3]); return w;
}
struct EpiUp {
    static constexpr bool PERM = true; static constexpr int HOOK_T = -1;
    bf16_t *AU, *GB; float* YB;
    __device__ __forceinline__ void mid(f32x4 (&)[2][2][4][2], const Unit&, int, int, int, int) const {}
    __device__ __forceinline__ void operator()(const f32x4 (&acc)[2][2][4][2], const Unit& u, int wr, int wc, int fr, int fq) const {
        asm volatile("" : "+v"(fr), "+v"(fq));
        const int row0 = u.pm * 256 + wr * 64 + fr; const int cl = wc * 32 + 8 * fq;
        if (u.nkt != 16) {
#pragma unroll
            for (int ai = 0; ai < 2; ++ai)
#pragma unroll
                for (int m = 0; m < 4; ++m) { const int r = row0 + ai * 128 + m * 16 - T_PROMPT; float* sp = up_slab(YB, u.kt0 >> 2, r, u.pn);
#pragma unroll
                    for (int bj = 0; bj < 2; ++bj) { *(f32x4*)(sp + bj * 128 + cl) = acc[ai][bj][m][0]; *(f32x4*)(sp + bj * 128 + cl + 4) = acc[ai][bj][m][1]; } }
            return;
        }
        bf16_t* base = (u.pn < 11) ? AU + u.pn * 256 : GB + (u.pn - 11) * 256;
#pragma unroll
        for (int ai = 0; ai < 2; ++ai)
#pragma unroll
            for (int m = 0; m < 4; ++m) { const int row = row0 + ai * 128 + m * 16;
#pragma unroll
                for (int bj = 0; bj < 2; ++bj) store8(base + (size_t)row * DFF + bj * 128 + cl, acc[ai][bj][m][0], acc[ai][bj][m][1]); }
    }
};
struct EpiDown {
    static constexpr bool PERM = false; static constexpr int HOOK_T = -1;
    const bf16_t* X1; const float *bias, *mod; float* Z; float* ZS;
    __device__ __forceinline__ void mid(f32x4 (&)[2][2][4][2], const Unit&, int, int, int, int) const {}
    __device__ __forceinline__ void operator()(const f32x4 (&acc)[2][2][4][2], const Unit& u, int wr, int wc, int fr, int fq) const {
        asm volatile("" : "+v"(fr), "+v"(fq));
        const int row0 = u.pm * 256 + wr * 64 + fr, col0 = u.pn * 256 + wc * 32 + 4 * fq;
#pragma unroll
        for (int ai = 0; ai < 2; ++ai)
#pragma unroll
            for (int m = 0; m < 4; ++m) { const int row = row0 + ai * 128 + m * 16; const int s = row_seq(row);
                const float* gc = mod + (size_t)s * 6144 + 5120;
#pragma unroll
                for (int bj = 0; bj < 2; ++bj)
#pragma unroll
                    for (int n = 0; n < 2; ++n) { const int c = col0 + bj * 128 + n * 16;
                        const u32x2 xw = *(const u32x2*)(X1 + (size_t)row * 1024 + c); const f32x4 bo = *(const f32x4*)(bias + c), gg = *(const f32x4*)(gc + c);
                        const f32x4 x1 = (f32x4){bf_lo(xw.x), bf_hi(xw.x), bf_lo(xw.y), bf_hi(xw.y)};
                        if (u.nkt != 44) { f32x4 v = gg * acc[ai][bj][m][n]; if (u.kt0 == 0) v += x1 * ALPHA + gg * bo;
                            *(f32x4*)(ZS + (size_t)(u.kt0 >> 2) * (512 * 1024) + (size_t)(row - T_PROMPT) * 1024 + c) = v; }
                        else *(f32x4*)(Z + (size_t)row * 1024 + c) = x1 * ALPHA + gg * (acc[ai][bj][m][n] + bo); }
                asm volatile("" ::: "memory"); }
    }
};

__device__ __forceinline__ int win_src_col(int n) {
    if (n < 4096) return n;
    if (n < 4352) return 6144 + (n - 4096);
    if (n < 6400) return 4096 + (n - 4352);
    if (n < 7168) return 6144 + 256 + (n - 6400);
    const int base = n < 9216 ? 7168 : 9216; const int r = n - base, p = r >> 8, w = r & 255;
    return w < 128 ? base + 128 * p + w : base + 1024 + 128 * p + (w - 128);
}
__device__ __forceinline__ void transpose_item(const float* W, int N, int k0, int nsrc0, bf16_t* WT, int ldk, int drow0, int kofs, LAS float* scr, int lane) {
    float tv[32];
#pragma unroll
    for (int i = 0; i < 32; ++i) tv[i] = W[(size_t)(k0 + 2 * i + (lane >> 5)) * N + nsrc0 + (lane & 31)];
#pragma unroll
    for (int i = 0; i < 32; ++i) scr[(2 * i + (lane >> 5)) * 33 + (lane & 31)] = tv[i];
    asm volatile("s_waitcnt lgkmcnt(0)" ::: "memory");
    const int c = lane & 7;
#pragma unroll
    for (int j = 0; j < 4; ++j) { const int n = (lane >> 3) + 8 * j; const LAS float* s = scr + (8 * c) * 33 + n;
        u32x4 o; o.x = cvt_pk_bf16(s[0 * 33], s[1 * 33]); o.y = cvt_pk_bf16(s[2 * 33], s[3 * 33]); o.z = cvt_pk_bf16(s[4 * 33], s[5 * 33]); o.w = cvt_pk_bf16(s[6 * 33], s[7 * 33]);
        *(u32x4*)(WT + (size_t)(drow0 + n) * ldk + kofs + k0 + 8 * c) = o; }
    asm volatile("s_waitcnt lgkmcnt(0)" ::: "memory");
}
__device__ __forceinline__ void phase0(const Params& p, LAS unsigned char* lds) {
    const int tid = threadIdx.x, wave = __builtin_amdgcn_readfirstlane(tid >> 6), lane = tid & 63;
    const int gw = blockIdx.x * 8 + wave, NGW = gridDim.x * 8;
    unsigned char* ws = p.ws;
    LAS float* scr = (LAS float*)(lds + wave * 8704);
    float* modp = (float*)(ws + OFF_MODP);
    constexpr int I_MOD = 1536, I_IN = 16 * 352, I_ORET = 32 * 32, I_OCONV = 16 * 32, I_OUT = 16 * 32, I_UP = 16 * 176, I_DOWN = 44 * 32;
    constexpr int NITEMS = I_MOD + I_IN + I_ORET + I_OCONV + I_OUT + I_UP + I_DOWN;
    for (int it = gw; it < NITEMS; it += NGW) {
        int r = it;
        if (r < I_MOD) {
            const int cgp = r % 96, kc = r / 96, n = cgp * 64 + lane, kb = kc * 64;
            float a[32];
#pragma unroll
            for (int s = 0; s < 32; ++s) a[s] = 0.f;
#pragma unroll 1
            for (int kq = 0; kq < 64; kq += 16) {
                float w[16];
#pragma unroll
                for (int j = 0; j < 16; ++j) w[j] = p.w_mod[(size_t)(kb + kq + j) * 6144 + n];
#pragma unroll
                for (int k = 0; k < 16; k += 4) {
#pragma unroll
                    for (int s = 0; s < 32; ++s) { const float* cp = (s < 16 ? p.c_prompt + s * 1024 : p.c_sample + (s - 16) * 1024) + kb + kq + k; const f32x4 cv = *(const f32x4*)cp;
                        a[s] += cv[0] * w[k] + cv[1] * w[k + 1] + cv[2] * w[k + 2] + cv[3] * w[k + 3]; }
                }
            }
#pragma unroll
            for (int s = 0; s < 32; ++s) modp[((size_t)kc * 32 + s) * 6144 + n] = a[s];
            continue;
        }
        r -= I_MOD;
        const float* W; int N, k0, nsrc0, ldk, drow0, kofs; bf16_t* WT;
        if (r < I_IN) { const int kb = r / 352, nb = r % 352; W = p.w_in; N = 11264; k0 = kb * 64; nsrc0 = win_src_col(nb * 32); WT = (bf16_t*)(ws + OFF_WIN); ldk = 1024; drow0 = nb * 32; kofs = 0; }
        else { r -= I_IN;
        if (r < I_ORET) { const int kb = r / 32, nb = r % 32; W = p.w_o_ret; N = 1024; k0 = kb * 64; nsrc0 = nb * 32; WT = (bf16_t*)(ws + OFF_WCAT); ldk = 3072; drow0 = nb * 32; kofs = 0; }
        else { r -= I_ORET;
        if (r < I_OCONV) { const int kb = r / 32, nb = r % 32; W = p.w_o_conv; N = 1024; k0 = kb * 64; nsrc0 = nb * 32; WT = (bf16_t*)(ws + OFF_WCAT); ldk = 3072; drow0 = nb * 32; kofs = 2048; }
        else { r -= I_OCONV;
        if (r < I_OUT) { const int kb = r / 32, nb = r % 32; W = p.w_out; N = 1024; k0 = kb * 64; nsrc0 = nb * 32; WT = (bf16_t*)(ws + OFF_WOUT); ldk = 1024; drow0 = nb * 32; kofs = 0; }
        else { r -= I_OUT;
        if (r < I_UP) { const int kb = r / 176, nb = r % 176; W = p.w_up; N = 5632; k0 = kb * 64; nsrc0 = nb * 32; WT = (bf16_t*)(ws + OFF_WUP); ldk = 1024; drow0 = nb * 32; kofs = 0; }
        else { r -= I_UP; const int kb = r / 32, nb = r % 32; W = p.w_down; N = 1024; k0 = kb * 64; nsrc0 = nb * 32; WT = (bf16_t*)(ws + OFF_WDOWN); ldk = 2816; drow0 = nb * 32; kofs = 0; } } } } }
        transpose_item(W, N, k0, nsrc0, WT, ldk, drow0, kofs, scr, lane);
    }
    float* rot = (float*)(ws + OFF_ROT);
    for (int idx = blockIdx.x * 512 + tid; idx < 2080 * 128; idx += gridDim.x * 512) {
        const int pos = idx >> 7, i = idx & 127;
        const float invf = exp2f(-(float)i * (13.287712379549449f / 128.0f));
        double rev = (double)pos * (double)invf * 0.15915494309189535; rev -= rint(rev);
        const float f = (float)rev;
        rot[2 * idx] = __builtin_amdgcn_cosf(f); rot[2 * idx + 1] = __builtin_amdgcn_sinf(f);
    }
}

__device__ __forceinline__ void phase1(const Params& p, LAS unsigned char* lds) {
    const int tid = threadIdx.x, wave = tid >> 6, lane = tid & 63;
    unsigned char* ws = p.ws;
    const float* modp = (const float*)(ws + OFF_MODP); float* mod = (float*)(ws + OFF_MOD); float* lnst = (float*)(ws + OFF_LNST);
    bf16_t* H = (bf16_t*)p.out;
    for (int i = blockIdx.x * 512 + tid; i < 32 * 6144; i += gridDim.x * 512) { const int n = i % 6144; float v = p.b_mod[n];
#pragma unroll
        for (int kc = 0; kc < 16; ++kc) v += modp[(size_t)kc * 32 * 6144 + i];
        mod[i] = v; }
    LAS float* lm = (LAS float*)lds;
    int s_have = -1;
    for (int grp = (int)(((long)blockIdx.x * 1040) / gridDim.x), gend = (int)(((long)(blockIdx.x + 1) * 1040) / gridDim.x); grp < gend; ++grp) {
        const int s = grp < 1024 ? (grp >> 6) : 16 + (grp - 1024);
        if (s != s_have) {
#pragma unroll
            for (int j = 0; j < 4; ++j) { const int idx = tid + 512 * j; float v = p.b_mod[idx];
#pragma unroll
                for (int kc = 0; kc < 16; ++kc) v += modp[((size_t)kc * 32 + s) * 6144 + idx];
                lm[idx] = v; }
            s_have = s;
        }
        __syncthreads();
        {
            const int rowb = grp * 32 + wave * 4;
            f32x4 v[4][4]; float mean[4], rstd[4];
#pragma unroll
            for (int rr = 0; rr < 4; ++rr) { const int row = rowb + rr;
                const float* xr = row < T_PROMPT ? p.x_prompt + (size_t)row * 1024 : p.x_sample + (size_t)(row - T_PROMPT) * 1024;
#pragma unroll
                for (int j = 0; j < 4; ++j) v[rr][j] = ((const f32x4*)xr)[lane + 64 * j]; }
#pragma unroll
            for (int rr = 0; rr < 4; ++rr) { float sm = 0.f;
#pragma unroll
                for (int j = 0; j < 4; ++j) sm += (v[rr][j][0] + v[rr][j][1]) + (v[rr][j][2] + v[rr][j][3]);
                mean[rr] = wave_sum(sm) * (1.0f / 1024.0f); float s2 = 0.f;
#pragma unroll
                for (int j = 0; j < 4; ++j) { v[rr][j] = v[rr][j] - mean[rr]; s2 += (v[rr][j][0] * v[rr][j][0] + v[rr][j][1] * v[rr][j][1]) + (v[rr][j][2] * v[rr][j][2] + v[rr][j][3] * v[rr][j][3]); }
                rstd[rr] = 1.0f / sqrtf(wave_sum(s2) * (1.0f / 1024.0f) + LN_EPS); }
#pragma unroll
            for (int j = 0; j < 4; ++j) { const int c = 4 * (lane + 64 * j);
                const f32x4 gv = *(const f32x4*)(p.ln_in_g + c), bv = *(const f32x4*)(p.ln_in_b + c);
                const f32x4 sh = *(const LAS f32x4*)(lm + c), sc = *(const LAS f32x4*)(lm + 1024 + c);
#pragma unroll
                for (int rr = 0; rr < 4; ++rr) { const f32x4 xl = v[rr][j] * rstd[rr] * gv + bv; const f32x4 h = xl * (sc + 1.0f) + sh;
                    u32x2 w; w.x = cvt_pk_bf16(h[0], h[1]); w.y = cvt_pk_bf16(h[2], h[3]);
                    *(u32x2*)(H + (size_t)(rowb + rr) * 1024 + c) = w; } }
            if (lane < 4) { lnst[2 * (rowb + lane)] = lane == 0 ? mean[0] : lane == 1 ? mean[1] : lane == 2 ? mean[2] : mean[3];
                            lnst[2 * (rowb + lane) + 1] = lane == 0 ? rstd[0] : lane == 1 ? rstd[1] : lane == 2 ? rstd[2] : rstd[3]; }
        }
        __syncthreads();
    }
}

constexpr int RT_QS = 264, RT_TS = 72;
#define LDS_BARRIER() do { asm volatile("s_waitcnt lgkmcnt(0)" ::: "memory"); __builtin_amdgcn_s_barrier(); asm volatile("" ::: "memory"); } while (0)
__device__ __forceinline__ void phase_retention(const Params& p, LAS unsigned char* lds, const bool dry) {
    const int tid0 = threadIdx.x, w = __builtin_amdgcn_readfirstlane(tid0 >> 6), l0 = tid0 & 63;
    unsigned char* ws = p.ws;
    const bf16_t* Qg = (const bf16_t*)(ws + OFF_Q); const bf16_t* Kg = (const bf16_t*)(ws + OFF_K);
    bf16_t* ACAT = (bf16_t*)(ws + OFF_ACAT); float* rst = (float*)(ws + OFF_RST);
    LAS bf16_t* Qn = (LAS bf16_t*)lds; LAS bf16_t* Kn = Qn + 64 * RT_QS; LAS bf16_t* KT = Kn + 64 * RT_QS;
    LAS bf16_t* VT = KT + 256 * RT_TS; LAS bf16_t* Pm = VT + 128 * RT_TS; LAS float* red = (LAS float*)(Pm + 64 * RT_TS);
    for (int item = blockIdx.x; item < 512; item += gridDim.x) {
        const bool samp = item >= 256; const int it = item & 255, xcd = it & 7, slot = it >> 3, sl = slot & 3, pr = (slot >> 2) * 8 + xcd, b = pr >> 2, h = pr & 3;
        const int Lc = samp ? 32 : 64, nch = samp ? 1 : 32;
        const size_t row0 = samp ? (size_t)(T_PROMPT + b * 32) : (size_t)b * 2048;
        const float lg2 = log2f(1.0f - exp2f(-5.0f - (float)h));
        const int ecol = h * 512 + sl * 128;
        f32x4 S[16];
        { const int l = l0, fr = l & 15, g = l >> 4;
        if (samp) { const float* sp = p.state_ret + ((size_t)(b * 4 + h) * 256) * 512 + sl * 128 + 16 * w + fr;
#pragma unroll
            for (int T = 0; T < 16; ++T)
#pragma unroll
                for (int i = 0; i < 4; ++i) S[T][i] = sp[(size_t)(16 * T + 4 * g + i) * 512];
        } else {
#pragma unroll
            for (int T = 0; T < 16; ++T) S[T] = (f32x4){0.f, 0.f, 0.f, 0.f};
        } }
        u32x4 rq[4], rk[4], rv[2];
#define RT_IDX int l = l0; asm volatile("" : "+v"(l)); const int tid = w * 64 + l, fr = l & 15, g = l >> 4; \
        const int k_dc = w * 4 + (l & 3), k_tpl = (l >> 2) & 15; const int v_ec = (w & 3) * 4 + (l & 3), v_tp = (w >> 2) * 16 + ((l >> 2) & 15); (void)tid; (void)fr; (void)g; (void)k_dc; (void)k_tpl; (void)v_ec; (void)v_tp;
#define RT_LOAD(c) do { const size_t rb = row0 + (size_t)(c) * 64; \
            _Pragma("unroll") for (int j = 0; j < 4; ++j) { const int idx = tid + 512 * j, tok = idx >> 5, ch = idx & 31; \
                rq[j] = tok < Lc ? *(const u32x4*)(Qg + (rb + tok) * 1024 + h * 256 + ch * 8) : (u32x4){0u, 0u, 0u, 0u}; } \
            _Pragma("unroll") for (int j = 0; j < 2; ++j) { const int t0 = 2 * (j * 16 + k_tpl); \
                rk[2 * j] = t0 < Lc ? *(const u32x4*)(Kg + (rb + t0) * 1024 + h * 256 + k_dc * 8) : (u32x4){0u, 0u, 0u, 0u}; \
                rk[2 * j + 1] = t0 + 1 < Lc ? *(const u32x4*)(Kg + (rb + t0 + 1) * 1024 + h * 256 + k_dc * 8) : (u32x4){0u, 0u, 0u, 0u}; } \
            { const int t0 = 2 * v_tp; \
              rv[0] = t0 < Lc ? *(const u32x4*)(ACAT + (rb + t0) * 3072 + ecol + v_ec * 8) : (u32x4){0u, 0u, 0u, 0u}; \
              rv[1] = t0 + 1 < Lc ? *(const u32x4*)(ACAT + (rb + t0 + 1) * 3072 + ecol + v_ec * 8) : (u32x4){0u, 0u, 0u, 0u}; } } while (0)
        { RT_IDX RT_LOAD(0); }
        const float sdec = exp2f(lg2 * (float)Lc);
        for (int c = 0; c < nch; ++c) {
            RT_IDX
            LDS_BARRIER();
#pragma unroll
            for (int j = 0; j < 4; ++j) { const int idx = tid + 512 * j, tok = idx >> 5, ch = idx & 31; *(LAS u32x4*)(Qn + tok * RT_QS + ch * 8) = rq[j]; }
#pragma unroll
            for (int j = 0; j < 2; ++j) { const int tp = j * 16 + k_tpl, t0 = 2 * tp;
                *(LAS u32x4*)(Kn + t0 * RT_QS + k_dc * 8) = rk[2 * j]; *(LAS u32x4*)(Kn + (t0 + 1) * RT_QS + k_dc * 8) = rk[2 * j + 1];
                const float f0 = exp2f(lg2 * (float)(Lc - 1 - t0)), f1 = exp2f(lg2 * (float)(Lc - 2 - t0));
#pragma unroll
                for (int q = 0; q < 4; ++q) { const unsigned a = rk[2 * j][q], bb = rk[2 * j + 1][q];
                    *(LAS unsigned*)(KT + (k_dc * 8 + 2 * q) * RT_TS + t0) = cvt_pk_bf16(bf_lo(a) * f0, bf_lo(bb) * f1);
                    *(LAS unsigned*)(KT + (k_dc * 8 + 2 * q + 1) * RT_TS + t0) = cvt_pk_bf16(bf_hi(a) * f0, bf_hi(bb) * f1); } }
            { const int t0 = 2 * v_tp;
#pragma unroll
                for (int q = 0; q < 4; ++q) { const unsigned a = rv[0][q], bb = rv[1][q];
                    *(LAS unsigned*)(VT + (v_ec * 8 + 2 * q) * RT_TS + t0) = (a & 0xffffu) | (bb << 16);
                    *(LAS unsigned*)(VT + (v_ec * 8 + 2 * q + 1) * RT_TS + t0) = (a >> 16) | (bb & 0xffff0000u); } }
            if (c + 1 < nch) RT_LOAD(c + 1);
            LDS_BARRIER();
            { const int qi = w >> 1;
#pragma unroll
                for (int tj = 0; tj < 2; ++tj) { const int kj = (w & 1) * 2 + tj; f32x4 d = (f32x4){0.f, 0.f, 0.f, 0.f};
                    if (kj <= qi) {
#pragma unroll
                        for (int ks = 0; ks < 8; ++ks) { const bf16x8 af = *(const LAS bf16x8*)(Kn + (16 * kj + fr) * RT_QS + 32 * ks + 8 * g);
                            const bf16x8 bfv = *(const LAS bf16x8*)(Qn + (16 * qi + fr) * RT_QS + 32 * ks + 8 * g);
                            d = __builtin_amdgcn_mfma_f32_16x16x32_bf16(af, bfv, d, 0, 0, 0); }
                    }
                    const int qq = 16 * qi + fr, k0 = 16 * kj + 4 * g; float o[4];
#pragma unroll
                    for (int i = 0; i < 4; ++i) { const int dk = qq - (k0 + i); o[i] = dk >= 0 ? d[i] * exp2f(lg2 * (float)dk) : 0.f; }
                    u32x2 pw; pw.x = cvt_pk_bf16(o[0], o[1]); pw.y = cvt_pk_bf16(o[2], o[3]);
                    *(LAS u32x2*)(Pm + qq * RT_TS + k0) = pw; } }
            LDS_BARRIER();
            bf16x8 Bv[2];
#pragma unroll
            for (int ks = 0; ks < 2; ++ks) Bv[ks] = *(const LAS bf16x8*)(VT + (16 * w + fr) * RT_TS + 32 * ks + 8 * g);
            f32x4 oacc[4];
#pragma unroll
            for (int mi = 0; mi < 4; ++mi) oacc[mi] = (f32x4){0.f, 0.f, 0.f, 0.f};
            {
                u32x2 qb[2][4][2];
#pragma unroll
                for (int mi = 0; mi < 4; ++mi) { qb[0][mi][0] = *(const LAS u32x2*)(Qn + (16 * mi + fr) * RT_QS + 4 * g); qb[0][mi][1] = *(const LAS u32x2*)(Qn + (16 * mi + fr) * RT_QS + 16 + 4 * g); }
#pragma unroll
                for (int ks = 0; ks < 8; ++ks) {
                    if (ks + 1 < 8) {
#pragma unroll
                        for (int mi = 0; mi < 4; ++mi) { qb[(ks + 1) & 1][mi][0] = *(const LAS u32x2*)(Qn + (16 * mi + fr) * RT_QS + 32 * (ks + 1) + 4 * g);
                            qb[(ks + 1) & 1][mi][1] = *(const LAS u32x2*)(Qn + (16 * mi + fr) * RT_QS + 32 * (ks + 1) + 16 + 4 * g); } }
                    union { bf16x8 v; unsigned u[4]; } sb;
                    sb.u[0] = cvt_pk_bf16(S[2 * ks][0], S[2 * ks][1]); sb.u[1] = cvt_pk_bf16(S[2 * ks][2], S[2 * ks][3]);
                    sb.u[2] = cvt_pk_bf16(S[2 * ks + 1][0], S[2 * ks + 1][1]); sb.u[3] = cvt_pk_bf16(S[2 * ks + 1][2], S[2 * ks + 1][3]);
#pragma unroll
                    for (int mi = 0; mi < 4; ++mi) { union { bf16x8 v; u32x2 h2[2]; } qa; qa.h2[0] = qb[ks & 1][mi][0]; qa.h2[1] = qb[ks & 1][mi][1];
                        oacc[mi] = __builtin_amdgcn_mfma_f32_16x16x32_bf16(qa.v, sb.v, oacc[mi], 0, 0, 0); }
                }
            }
#pragma unroll
            for (int mi = 0; mi < 4; ++mi)
#pragma unroll
                for (int i = 0; i < 4; ++i) oacc[mi][i] *= exp2f(lg2 * (float)(16 * mi + 4 * g + i + 1));
#pragma unroll
            for (int mi = 0; mi < 4; ++mi) {
#pragma unroll
                for (int ks = 0; ks < 2; ++ks) { const bf16x8 af = *(const LAS bf16x8*)(Pm + (16 * mi + fr) * RT_TS + 32 * ks + 8 * g);
                    oacc[mi] = __builtin_amdgcn_mfma_f32_16x16x32_bf16(af, Bv[ks], oacc[mi], 0, 0, 0); }
            }
            __builtin_amdgcn_sched_barrier(0);
#pragma unroll
            for (int mi = 0; mi < 4; ++mi)
#pragma unroll
                for (int i = 0; i < 4; ++i) Kn[(16 * mi + 4 * g + i) * 136 + 16 * w + fr] = (bf16_t)(cvt_pk_bf16(oacc[mi][i], 0.f) & 0xffffu);
            __builtin_amdgcn_sched_barrier(0);
            {
                bf16x8 kf[2][2];
#pragma unroll
                for (int ks = 0; ks < 2; ++ks) kf[0][ks] = *(const LAS bf16x8*)(KT + fr * RT_TS + 32 * ks + 8 * g);
#pragma unroll
                for (int T = 0; T < 16; ++T) {
                    if (T + 1 < 16) {
#pragma unroll
                        for (int ks = 0; ks < 2; ++ks) kf[(T + 1) & 1][ks] = *(const LAS bf16x8*)(KT + (16 * (T + 1) + fr) * RT_TS + 32 * ks + 8 * g); }
                    S[T] *= sdec;
#pragma unroll
                    for (int ks = 0; ks < 2; ++ks) S[T] = __builtin_amdgcn_mfma_f32_16x16x32_bf16(kf[T & 1][ks], Bv[ks], S[T], 0, 0, 0);
                }
            }
            LDS_BARRIER();
            { const int q = tid >> 3, seg = tid & 7;
              const u32x4 v0 = *(const LAS u32x4*)(Kn + q * 136 + 16 * seg), v1 = *(const LAS u32x4*)(Kn + q * 136 + 16 * seg + 8);
              float s1 = 0.f, s2 = 0.f;
#pragma unroll
              for (int e = 0; e < 4; ++e) { const float a0 = bf_lo(v0[e]), a1 = bf_hi(v0[e]), b0 = bf_lo(v1[e]), b1 = bf_hi(v1[e]);
                  s1 += (a0 + a1) + (b0 + b1); s2 += (a0 * a0 + a1 * a1) + (b0 * b0 + b1 * b1); }
#pragma unroll
              for (int off = 1; off < 8; off <<= 1) { s1 += __shfl_xor(s1, off); s2 += __shfl_xor(s2, off); }
              if (q < Lc && !dry) { const size_t row = row0 + (size_t)c * 64 + q;
                  bf16_t* op = ACAT + row * 3072 + ecol + 16 * seg; *(u32x4*)op = v0; *(u32x4*)(op + 8) = v1;
                  if (seg == 0) { float* dst = rst + ((row * 4 + h) * 4 + sl) * 2; dst[0] = s1; dst[1] = s2; } } }
        }
#undef RT_LOAD
#undef RT_IDX
        { const int l = l0, fr = l & 15, g = l >> 4; float* so = p.out + (samp ? OUT_RETS : OUT_RETP) + ((size_t)(b * 4 + h) * 256) * 512 + sl * 128 + 16 * w + fr;
#pragma unroll
            for (int T = 0; T < 16; ++T)
#pragma unroll
                for (int i = 0; i < 4; ++i) if (!dry) so[(size_t)(16 * T + 4 * g + i) * 512] = S[T][i]; }
    }
}

__device__ __forceinline__ void unpack8(const u32x4 w, float (&f)[8]) {
#pragma unroll
    for (int q = 0; q < 4; ++q) { f[2 * q] = bf_lo(w[q]); f[2 * q + 1] = bf_hi(w[q]); }
}
__device__ __forceinline__ void phase_mix_elem(const Params& p, const bool dry) {
    unsigned char* ws = p.ws;
    bf16_t* ACAT = (bf16_t*)(ws + OFF_ACAT); const bf16_t* G = (const bf16_t*)(ws + OFF_G); const bf16_t* U = (const bf16_t*)(ws + OFF_U);
    const float* rst = (const float*)(ws + OFF_RST);
    const int gt = blockIdx.x * 512 + threadIdx.x; const int NS = (gridDim.x * 512) / 384; const int stream = gt / 384, cc = gt % 384;
    if (stream >= NS) return;
    const int rows_per = (T_ALL + NS - 1) / NS; const int r0 = stream * rows_per; const int r1 = min(r0 + rows_per, T_ALL);
    if (cc < 256) {
        const int j = cc >> 6, col = 8 * cc;
        for (int rb = r0; rb < r1; rb += 4) {
            u32x4 ov[4], gv[4]; f32x4 sa[4], sb[4];
#pragma unroll
            for (int i = 0; i < 4; ++i) { const int row = min(rb + i, r1 - 1);
                ov[i] = *(const u32x4*)(ACAT + (size_t)row * 3072 + col); gv[i] = *(const u32x4*)(G + (size_t)row * 2048 + col);
                const float* st = rst + ((size_t)row * 4 + j) * 8; sa[i] = *(const f32x4*)st; sb[i] = *(const f32x4*)(st + 4); }
#pragma unroll
            for (int i = 0; i < 4; ++i) { const int row = rb + i;
                const float s1 = (sa[i][0] + sa[i][2]) + (sb[i][0] + sb[i][2]), s2 = (sa[i][1] + sa[i][3]) + (sb[i][1] + sb[i][3]);
                const float mu = s1 * (1.0f / 512.0f); const float var = fmaxf(s2 * (1.0f / 512.0f) - mu * mu, 0.f); const float rstd = 1.0f / sqrtf(var + LN_EPS);
                u32x4 r;
#pragma unroll
                for (int q = 0; q < 4; ++q) { const float g0 = bf_lo(gv[i][q]), g1 = bf_hi(gv[i][q]);
                    const float a0 = g0 * sigmoidf_(g0) * ((bf_lo(ov[i][q]) - mu) * rstd), a1 = g1 * sigmoidf_(g1) * ((bf_hi(ov[i][q]) - mu) * rstd);
                    r[q] = cvt_pk_bf16(a0, a1); }
                if (row < r1 && !dry) *(u32x4*)(ACAT + (size_t)row * 3072 + col) = r; }
        }
    } else {
        const int c = 8 * (cc - 256);
        float cb[8], w0[8], w1[8], w2[8], um1[8], um2[8];
#pragma unroll
        for (int e = 0; e < 8; ++e) { cb[e] = p.conv_b[c + e]; w0[e] = p.conv_w[c + e]; w1[e] = p.conv_w[1024 + c + e]; w2[e] = p.conv_w[2048 + c + e]; um1[e] = 0.f; um2[e] = 0.f; }
        { const int row = r0; const bool samp = row >= T_PROMPT; const int t = samp ? ((row - T_PROMPT) & 31) : (row & 2047); const int bl = samp ? ((row - T_PROMPT) >> 5) : (row >> 11);
          if (t >= 1) unpack8(*(const u32x4*)(U + (size_t)(row - 1) * 1024 + c), um1);
          if (t >= 2) unpack8(*(const u32x4*)(U + (size_t)(row - 2) * 1024 + c), um2);
          else if (t == 1 && samp) {
#pragma unroll
              for (int e = 0; e < 8; ++e) um2[e] = p.state_conv[((size_t)bl * 2 + 1) * 1024 + c + e]; } }
        for (int rb = r0; rb < r1; rb += 4) {
            u32x4 bg[4], uv[4];
#pragma unroll
            for (int i = 0; i < 4; ++i) { const int row = min(rb + i, r1 - 1);
                bg[i] = *(const u32x4*)(ACAT + (size_t)row * 3072 + 2048 + c); uv[i] = *(const u32x4*)(U + (size_t)row * 1024 + c); }
#pragma unroll
            for (int i = 0; i < 4; ++i) { const int row = rb + i;
                if (row < r1) {
                    const bool samp = row >= T_PROMPT; const int t = samp ? ((row - T_PROMPT) & 31) : (row & 2047); const int L = samp ? 32 : 2048; const int bl = samp ? ((row - T_PROMPT) >> 5) : (row >> 11);
                    if (t == 0) {
#pragma unroll
                        for (int e = 0; e < 8; ++e) { um1[e] = samp ? p.state_conv[((size_t)bl * 2 + 1) * 1024 + c + e] : 0.f; um2[e] = samp ? p.state_conv[((size_t)bl * 2) * 1024 + c + e] : 0.f; } }
                    float uc[8], bgf[8], res[8]; unpack8(uv[i], uc); unpack8(bg[i], bgf);
#pragma unroll
                    for (int e = 0; e < 8; ++e) { res[e] = bgf[e] * (cb[e] + w0[e] * um2[e] + w1[e] * um1[e] + w2[e] * uc[e]); um2[e] = um1[e]; um1[e] = uc[e]; }
                    if (!dry) { u32x4 r; r.x = cvt_pk_bf16(res[0], res[1]); r.y = cvt_pk_bf16(res[2], res[3]); r.z = cvt_pk_bf16(res[4], res[5]); r.w = cvt_pk_bf16(res[6], res[7]);
                        *(u32x4*)(ACAT + (size_t)row * 3072 + 2048 + c) = r;
                        if (t >= L - 2) { float* so = p.out + (samp ? OUT_CONVS : OUT_CONVP) + ((size_t)bl * 2 + (t - (L - 2))) * 1024 + c;
                            *(f32x4*)so = (f32x4){uc[0], uc[1], uc[2], uc[3]}; *(f32x4*)(so + 4) = (f32x4){uc[4], uc[5], uc[6], uc[7]}; } }
                } }
        }
    }
}

__device__ __forceinline__ void phase_ln1(const Params& p, const bool dry) {
    const int tid = threadIdx.x, wave = tid >> 6, lane = tid & 63;
    unsigned char* ws = p.ws;
    const float* mod = (const float*)(ws + OFF_MOD); bf16_t* X1 = (bf16_t*)(ws + OFF_X1);
    for (int rowb = (blockIdx.x * 8 + wave) * 4; rowb < T_ALL; rowb += gridDim.x * 32) {
        const int s = row_seq(rowb);
        f32x4 v[4][4]; float rstd[4];
#pragma unroll
        for (int rr = 0; rr < 4; ++rr)
#pragma unroll
            for (int j = 0; j < 4; ++j) {
                if (rowb < T_PROMPT) v[rr][j] = ((const f32x4*)(p.out + (size_t)(rowb + rr) * 1024))[lane + 64 * j];
                else { const float* zs = (const float*)(ws + OFF_MS32) + (size_t)(rowb + rr - T_PROMPT) * 1024;
                    v[rr][j] = (((const f32x4*)zs)[lane + 64 * j] + ((const f32x4*)(zs + 512 * 1024))[lane + 64 * j]) + (((const f32x4*)(zs + 2 * 512 * 1024))[lane + 64 * j] + ((const f32x4*)(zs + 3 * 512 * 1024))[lane + 64 * j]); } }
#pragma unroll
        for (int rr = 0; rr < 4; ++rr) { float sm = 0.f;
#pragma unroll
            for (int j = 0; j < 4; ++j) sm += (v[rr][j][0] + v[rr][j][1]) + (v[rr][j][2] + v[rr][j][3]);
            const float mean = wave_sum(sm) * (1.0f / 1024.0f); float s2 = 0.f;
#pragma unroll
            for (int j = 0; j < 4; ++j) { v[rr][j] = v[rr][j] - mean; s2 += (v[rr][j][0] * v[rr][j][0] + v[rr][j][1] * v[rr][j][1]) + (v[rr][j][2] * v[rr][j][2] + v[rr][j][3] * v[rr][j][3]); }
            rstd[rr] = 1.0f / sqrtf(wave_sum(s2) * (1.0f / 1024.0f) + LN_EPS); }
#pragma unroll
        for (int j = 0; j < 4; ++j) { const int c = 4 * (lane + 64 * j);
            const f32x4 gv = *(const f32x4*)(p.ln1_g + c), bv = *(const f32x4*)(p.ln1_b + c);
            const f32x4 sh = *(const f32x4*)(mod + (size_t)s * 6144 + 3072 + c), sc = *(const f32x4*)(mod + (size_t)s * 6144 + 4096 + c);
#pragma unroll
            for (int rr = 0; rr < 4; ++rr) { const int row = rowb + rr;
                const f32x4 x1 = v[rr][j] * rstd[rr] * gv + bv; const f32x4 hh = x1 * (sc + 1.0f) + sh;
                u32x2 w; w.x = cvt_pk_bf16(x1[0], x1[1]); w.y = cvt_pk_bf16(x1[2], x1[3]);
                u32x2 w2; w2.x = cvt_pk_bf16(hh[0], hh[1]); w2.y = cvt_pk_bf16(hh[2], hh[3]);
                if (!dry) { *(u32x2*)(X1 + (size_t)row * 1024 + c) = w; *(u32x2*)((bf16_t*)p.out + (size_t)row * 2048 + c) = w2; } } }
    }
}

__device__ __forceinline__ void phase_ffn_elem(const Params& p, const bool dry) {
    unsigned char* ws = p.ws;
    const bf16_t* AU = (const bf16_t*)(ws + OFF_AU); bf16_t* GBF = (bf16_t*)(ws + OFF_GBF);
    const int gt = blockIdx.x * 512 + threadIdx.x; const int NS = (gridDim.x * 512) / 352; const int stream = gt / 352, cc = gt % 352;
    if (stream >= NS) return;
    constexpr int UNITS = T_PROMPT + 6 * (T_ALL - T_PROMPT);
    const int u0 = (int)(((long)stream * UNITS) / NS), u1 = (int)(((long)(stream + 1) * UNITS) / NS);
    const int r0 = u0 <= T_PROMPT ? u0 : T_PROMPT + (u0 - T_PROMPT + 5) / 6, r1 = u1 <= T_PROMPT ? u1 : T_PROMPT + (u1 - T_PROMPT + 5) / 6;
    if (r0 >= r1) return;
    const int c = 8 * cc;
    float cb[8], w0[8], w1[8], w2[8], am1[8], am2[8];
#pragma unroll
    for (int e = 0; e < 8; ++e) { cb[e] = p.ffn_conv_b[c + e]; w0[e] = p.ffn_conv_w[c + e]; w1[e] = p.ffn_conv_w[DFF + c + e]; w2[e] = p.ffn_conv_w[2 * DFF + c + e]; am1[e] = 0.f; am2[e] = 0.f; }
    { const int row = r0; const bool samp = row >= T_PROMPT; const int t = samp ? ((row - T_PROMPT) & 31) : (row & 2047); const int bl = samp ? ((row - T_PROMPT) >> 5) : (row >> 11);
      if (t >= 1) unpack8(samp ? up_slab_sum8(p.out, row - 1 - T_PROMPT, c >> 8, c & 255) : *(const u32x4*)(AU + (size_t)(row - 1) * DFF + c), am1);
      if (t >= 2) unpack8(samp ? up_slab_sum8(p.out, row - 2 - T_PROMPT, c >> 8, c & 255) : *(const u32x4*)(AU + (size_t)(row - 2) * DFF + c), am2);
      else if (t == 1 && samp) {
#pragma unroll
          for (int e = 0; e < 8; ++e) am2[e] = p.state_ffn[((size_t)bl * 2 + 1) * DFF + c + e]; } }
#define FFN_GROUP(REND, LOADS) \
    for (; rb < (REND); rb += 4) { \
        u32x4 av[4], gv[4]; \
        _Pragma("unroll") for (int i = 0; i < 4; ++i) { const int row = min(rb + i, (REND) - 1); LOADS } \
        _Pragma("unroll") for (int i = 0; i < 4; ++i) { const int row = rb + i; \
            if (row < (REND)) { \
                const bool samp = row >= T_PROMPT; const int t = samp ? ((row - T_PROMPT) & 31) : (row & 2047); const int L = samp ? 32 : 2048; const int bl = samp ? ((row - T_PROMPT) >> 5) : (row >> 11); \
                if (t == 0) { \
                    _Pragma("unroll") for (int e = 0; e < 8; ++e) { am1[e] = samp ? p.state_ffn[((size_t)bl * 2 + 1) * DFF + c + e] : 0.f; am2[e] = samp ? p.state_ffn[((size_t)bl * 2) * DFF + c + e] : 0.f; } } \
                float ac[8], gf[8], res[8]; unpack8(av[i], ac); unpack8(gv[i], gf); \
                _Pragma("unroll") for (int e = 0; e < 8; ++e) { res[e] = gelu_f(cb[e] + w0[e] * am2[e] + w1[e] * am1[e] + w2[e] * ac[e]) * gf[e]; am2[e] = am1[e]; am1[e] = ac[e]; } \
                if (!dry) { u32x4 r; r.x = cvt_pk_bf16(res[0], res[1]); r.y = cvt_pk_bf16(res[2], res[3]); r.z = cvt_pk_bf16(res[4], res[5]); r.w = cvt_pk_bf16(res[6], res[7]); \
                    *(u32x4*)(GBF + (size_t)row * DFF + c) = r; \
                    if (t >= L - 2) { float* so = p.out + (samp ? OUT_FFNS : OUT_FFNP) + ((size_t)bl * 2 + (t - (L - 2))) * DFF + c; \
                        *(f32x4*)so = (f32x4){ac[0], ac[1], ac[2], ac[3]}; *(f32x4*)(so + 4) = (f32x4){ac[4], ac[5], ac[6], ac[7]}; } } \
            } } \
    }
    int rb = r0;
    { const int rp = min(r1, T_PROMPT);
      FFN_GROUP(rp, av[i] = *(const u32x4*)(AU + (size_t)row * DFF + c); gv[i] = *(const u32x4*)(GBF + (size_t)row * DFF + c);) }
    rb = max(r0, T_PROMPT);
    FFN_GROUP(r1, av[i] = up_slab_sum8(p.out, row - T_PROMPT, c >> 8, c & 255); gv[i] = up_slab_sum8(p.out, row - T_PROMPT, 11 + (c >> 8), c & 255);)
#undef FFN_GROUP
}

__device__ __forceinline__ void phase_ln2(const Params& p, const bool dry) {
    const int tid = threadIdx.x, wave = tid >> 6, lane = tid & 63;
    for (int rowb = (blockIdx.x * 8 + wave) * 4; rowb < T_ALL; rowb += gridDim.x * 32) {
        f32x4 v[4][4]; float rstd[4];
#pragma unroll
        for (int rr = 0; rr < 4; ++rr)
#pragma unroll
            for (int j = 0; j < 4; ++j) {
                if (rowb < T_PROMPT) v[rr][j] = ((const f32x4*)(p.out + (size_t)(rowb + rr) * 1024))[lane + 64 * j];
                else { const float* zs = (const float*)(p.ws + OFF_AU) + (size_t)(rowb + rr - T_PROMPT) * 1024; f32x4 a = ((const f32x4*)zs)[lane + 64 * j];
#pragma unroll
                    for (int k = 1; k < 11; ++k) a += ((const f32x4*)(zs + (size_t)k * 512 * 1024))[lane + 64 * j];
                    v[rr][j] = a; } }
#pragma unroll
        for (int rr = 0; rr < 4; ++rr) { float sm = 0.f;
#pragma unroll
            for (int j = 0; j < 4; ++j) sm += (v[rr][j][0] + v[rr][j][1]) + (v[rr][j][2] + v[rr][j][3]);
            const float mean = wave_sum(sm) * (1.0f / 1024.0f); float s2 = 0.f;
#pragma unroll
            for (int j = 0; j < 4; ++j) { v[rr][j] = v[rr][j] - mean; s2 += (v[rr][j][0] * v[rr][j][0] + v[rr][j][1] * v[rr][j][1]) + (v[rr][j][2] * v[rr][j][2] + v[rr][j][3] * v[rr][j][3]); }
            rstd[rr] = 1.0f / sqrtf(wave_sum(s2) * (1.0f / 1024.0f) + LN_EPS); }
#pragma unroll
        for (int j = 0; j < 4; ++j) { const int c = 4 * (lane + 64 * j);
            const f32x4 gv = *(const f32x4*)(p.ln2_g + c), bv = *(const f32x4*)(p.ln2_b + c);
#pragma unroll
            for (int rr = 0; rr < 4; ++rr) if (!dry) ((f32x4*)(p.out + (size_t)(rowb + rr) * 1024))[lane + 64 * j] = v[rr][j] * rstd[rr] * gv + bv; }
    }
}

#define XB_TMO      128
#define XB_XCNT(j)  (256  + 64 * (j))
#define XB_XSUB(j)  (1280 + 64 * (j))
#define XB_XGEN(j)  (2304 + 64 * (j))
#define XB_TOP      3328
#define XB_TOPGEN   3392
#define XCD_BAR_WORDS 3456
#define XB_SPIN_CAP (1u << 22)
__device__ __forceinline__ unsigned xb_ld(unsigned* p)              { return __hip_atomic_load(p, __ATOMIC_RELAXED, __HIP_MEMORY_SCOPE_AGENT); }
__device__ __forceinline__ unsigned xb_add(unsigned* p, unsigned v) { return __hip_atomic_fetch_add(p, v, __ATOMIC_RELAXED, __HIP_MEMORY_SCOPE_AGENT); }
__device__ __forceinline__ unsigned xb_xcc_id() { return (unsigned)__builtin_amdgcn_s_getreg((3 << 11) | 20) & 0xFu; }
#define XB_SPIN(cond, bar) do { unsigned _sp = 0; while (cond) { __builtin_amdgcn_s_sleep(1); \
    if ((++_sp & 255u) == 0u) { if (xb_ld(&(bar)[XB_TMO])) break; if (_sp > XB_SPIN_CAP) { atomicAdd(&(bar)[XB_TMO], 1u); break; } } } } while (0)
struct XcdBarrier { unsigned* bar; unsigned x; volatile LAS unsigned* st; };
__device__ __forceinline__ XcdBarrier xcd_barrier_post(unsigned* bar, volatile LAS unsigned* st) {
    XcdBarrier b; b.bar = bar; b.x = xb_xcc_id(); b.st = st;
    if (threadIdx.x == 0) (void)xb_add(&bar[XB_XCNT(b.x)], 1u);
    return b;
}
__device__ __forceinline__ void xcd_barrier_complete(unsigned* bar, unsigned x, unsigned& nloc, unsigned& nx) {
    const unsigned G = gridDim.x * gridDim.y * gridDim.z;
    unsigned sum, cnt, mine, sp = 0u;
    for (;;) {
        sum = 0u; cnt = 0u; mine = 0u;
#pragma unroll
        for (unsigned j = 0; j < 16; ++j) { const unsigned c = xb_ld(&bar[XB_XCNT(j)]); sum += c; cnt += (c > 0u) ? 1u : 0u; mine = (j == x) ? c : mine; }
        if (sum == G) break;
        __builtin_amdgcn_s_sleep(1);
        if ((++sp & 255u) == 0u) { if (xb_ld(&bar[XB_TMO])) break; if (sp > XB_SPIN_CAP) { atomicAdd(&bar[XB_TMO], 1u); break; } }
    }
    nloc = mine > 0u ? mine : 1u; nx = cnt > 0u ? cnt : 1u;
}
__device__ __forceinline__ void xcd_barrier(const XcdBarrier& b) {
    asm volatile("s_waitcnt vmcnt(0)" ::: "memory");
    __syncthreads();
    if (threadIdx.x == 0) {
        unsigned* bar = b.bar;
        __builtin_amdgcn_s_waitcnt(0);
        unsigned nloc = b.st[0], nx = b.st[1];
        if (nloc == 0u) { xcd_barrier_complete(bar, b.x, nloc, nx); b.st[0] = nloc; b.st[1] = nx; }
        const unsigned old = xb_add(&bar[XB_XSUB(b.x)], 1u);
        const unsigned gen = old / nloc;
        if (old + 1u == (gen + 1u) * nloc) {
            __builtin_amdgcn_fence(__ATOMIC_RELEASE, "agent");
            asm volatile("s_waitcnt vmcnt(0)" ::: "memory");
            const unsigned og = xb_add(&bar[XB_TOP], 1u);
            const unsigned tg = og / nx;
            if (og + 1u == (tg + 1u) * nx) xb_add(&bar[XB_TOPGEN], 1u);
            else XB_SPIN(xb_ld(&bar[XB_TOPGEN]) == tg, bar);
            __builtin_amdgcn_fence(__ATOMIC_ACQUIRE, "agent");
            xb_add(&bar[XB_XGEN(b.x)], 1u);
            asm volatile("s_waitcnt vmcnt(0)" ::: "memory");
        } else {
            XB_SPIN(xb_ld(&bar[XB_XGEN(b.x)]) == gen, bar);
            __builtin_amdgcn_fence(__ATOMIC_ACQUIRE, "agent");
            asm volatile("s_waitcnt vmcnt(0)" ::: "memory");
        }
    }
    __syncthreads();
}

constexpr int NPHASES = 14;
#ifndef WGM_N1024
#define WGM_N1024 8
#endif
#ifndef WGM_UP
#define WGM_UP 4
#endif
#ifndef WGM_IN0
#define WGM_IN0 4
#endif
#ifndef WGM_IN1
#define WGM_IN1 4
#endif
#ifndef WGM_IN2
#define WGM_IN2 4
#endif
#ifndef REP_MASK
#define REP_MASK 0
#endif
#ifndef PH_MASK
#define PH_MASK 0xFFFF
#endif
#define PH_ON(k) ((PH_MASK >> (k)) & 1)
__global__ void __launch_bounds__(512, 2) mega_fwd(Params p) {
    extern __shared__ __attribute__((aligned(16))) unsigned char shm[];
    LAS unsigned char* lds = (LAS unsigned char*)shm;
    cg::grid_group grid = cg::this_grid();
    unsigned char* ws = p.ws;
    if (threadIdx.x < 4) ((LAS unsigned*)(lds + LDS_BAR_OFF))[threadIdx.x] = 0u;
    __syncthreads();
    const XcdBarrier xbar = xcd_barrier_post((unsigned*)(ws + OFF_BAR), (volatile LAS unsigned*)(lds + LDS_BAR_OFF));
    const int G = gridDim.x, c = blockIdx.x;
    const int lo = p.ph_lo, hi = p.ph_hi;
#define PH_SYNC(k) do { if ((k) + 1 < hi) { if (lo > 1000) grid.sync(); else xcd_barrier(xbar); } } while (0)
    if (lo <= 0 && 0 < hi) { if constexpr (PH_ON(0)) { for (int rep = (p.rep_mask >> 0) & 1; rep >= 0; --rep) phase0(p, lds); } PH_SYNC(0); }
    if (lo <= 1 && 1 < hi) { if constexpr (PH_ON(1)) { for (int rep = (p.rep_mask >> 1) & 1; rep >= 0; --rep) phase1(p, lds); } PH_SYNC(1); }
    if (lo <= 2 && 2 < hi) { if constexpr (PH_ON(2)) { { pg8::Gemm g{(const bf16_t*)p.out, (const bf16_t*)(ws + OFF_WIN), T_ALL, 17 * 256, 1024, 1024}; pg8::StaticOrder S; S.init(g.M, g.N, G, c, g.K);
            EpiIn<0> E{(bf16_t*)(ws + OFF_Q), (bf16_t*)(ws + OFF_K), (bf16_t*)(ws + OFF_ACAT), nullptr, nullptr, nullptr, nullptr, (const float*)(ws + OFF_ROT)};
            S.total = S.nwg << ((p.rep_mask >> 2) & 1); S.wgm = WGM_IN0; pg8::gemm_phase(lds, g, S, E); } } PH_SYNC(2); }
    if (lo <= 3 && 3 < hi) { if constexpr (PH_ON(3)) { for (int rep = (p.rep_mask >> 3) & 1; rep >= 0; --rep) phase_retention(p, lds, rep > 0); } PH_SYNC(3); }
    if (lo <= 4 && 4 < hi) { if constexpr (PH_ON(4)) { { pg8::Gemm g{(const bf16_t*)p.out, (const bf16_t*)(ws + OFF_WIN) + (size_t)17 * 256 * 1024, T_ALL, 19 * 256, 1024, 1024}; pg8::StaticOrder S; S.init(g.M, g.N, G, c, g.K);
            EpiIn<1> E{nullptr, nullptr, (bf16_t*)(ws + OFF_ACAT), (bf16_t*)(ws + OFF_G), (bf16_t*)(ws + OFF_U), (bf16_t*)(ws + OFF_RS_S), (bf16_t*)(ws + OFF_RS_S) + 512 * 1024, nullptr};
            S.wgm = WGM_IN1; S.add_extra(128, 2, 19, 8); pg8::gemm_phase(lds, g, S, E); } } PH_SYNC(4); }
    if (lo <= 5 && 5 < hi) { if constexpr (PH_ON(5)) { for (int rep = (p.rep_mask >> 5) & 1; rep >= 0; --rep) phase_mix_elem(p, rep > 0); } PH_SYNC(5); }
    if (lo <= 6 && 6 < hi) { if constexpr (PH_ON(6)) { { pg8::Gemm g{(const bf16_t*)p.out, (const bf16_t*)(ws + OFF_WIN) + (size_t)36 * 256 * 1024, T_PROMPT, 8 * 256, 1024, 1024}; pg8::StaticOrder S; S.init(g.M, g.N, G, c, g.K);
            EpiIn<2> E{nullptr, nullptr, nullptr, nullptr, nullptr, (bf16_t*)(ws + OFF_R), (bf16_t*)(ws + OFF_SC), nullptr};
            S.total = S.nwg << ((p.rep_mask >> 6) & 1); S.wgm = WGM_IN2; pg8::gemm_phase(lds, g, S, E); } } PH_SYNC(6); }
    if (lo <= 7 && 7 < hi) { if constexpr (PH_ON(7)) { { pg8::Gemm g{(const bf16_t*)(ws + OFF_ACAT), (const bf16_t*)(ws + OFF_WCAT), T_ALL, 1024, 3072, 3072}; pg8::StaticOrder S; S.init(g.M, g.N, G, c, g.K);
            EpiMerged E{(const bf16_t*)(ws + OFF_R), (const bf16_t*)(ws + OFF_SC), (bf16_t*)(ws + OFF_MERGED), (float*)(ws + OFF_MS32), (const bf16_t*)(ws + OFF_RS_S), (const bf16_t*)(ws + OFF_RS_S) + 512 * 1024};
            S.wgm = WGM_N1024; S.split_tail(2, 4); pg8::gemm_phase(lds, g, S, E); }
            xcd_barrier(xbar);
            { const float* ms = (const float*)(ws + OFF_MS32); bf16_t* mo = (bf16_t*)(ws + OFF_MERGED) + (size_t)T_PROMPT * 1024;
              for (int i = blockIdx.x * 512 + threadIdx.x; i < 512 * 1024 / 4; i += gridDim.x * 512) { f32x4 v = ((const f32x4*)ms)[i];
#pragma unroll
                  for (int k = 1; k < 12; ++k) v += ((const f32x4*)(ms + (size_t)k * 512 * 1024))[i];
                  u32x2 w; w.x = cvt_pk_bf16(v[0], v[1]); w.y = cvt_pk_bf16(v[2], v[3]); ((u32x2*)mo)[i] = w; } } } PH_SYNC(7); }
    if (lo <= 8 && 8 < hi) { if constexpr (PH_ON(8)) { { pg8::Gemm g{(const bf16_t*)(ws + OFF_MERGED), (const bf16_t*)(ws + OFF_WOUT), T_ALL, 1024, 1024, 1024}; pg8::StaticOrder S; S.init(g.M, g.N, G, c, g.K);
            EpiOut E{p.x_prompt, p.x_sample, (const float*)(ws + OFF_LNST), p.ln_in_g, p.ln_in_b, p.b_out, (const float*)(ws + OFF_MOD), p.out, (float*)(ws + OFF_MS32)};
            S.wgm = WGM_N1024; S.split_tail(2, 4); pg8::gemm_phase(lds, g, S, E); } } PH_SYNC(8); }
    if (lo <= 9 && 9 < hi) { if constexpr (PH_ON(9)) { for (int rep = (p.rep_mask >> 9) & 1; rep >= 0; --rep) phase_ln1(p, rep > 0); } PH_SYNC(9); }
    if (lo <= 10 && 10 < hi) { if constexpr (PH_ON(10)) { { pg8::Gemm g{(const bf16_t*)p.out, (const bf16_t*)(ws + OFF_WUP), T_ALL, 5632, 1024, 2048}; pg8::StaticOrder S; S.init(g.M, g.N, G, c, g.K);
            EpiUp E{(bf16_t*)(ws + OFF_AU), (bf16_t*)(ws + OFF_GBF), p.out};
            S.wgm = WGM_UP; S.split_tail(2, 4); pg8::gemm_phase(lds, g, S, E); } } PH_SYNC(10); }
    if (lo <= 11 && 11 < hi) { if constexpr (PH_ON(11)) { for (int rep = (p.rep_mask >> 11) & 1; rep >= 0; --rep) phase_ffn_elem(p, rep > 0); } PH_SYNC(11); }
    if (lo <= 12 && 12 < hi) { if constexpr (PH_ON(12)) { { pg8::Gemm g{(const bf16_t*)(ws + OFF_GBF), (const bf16_t*)(ws + OFF_WDOWN), T_ALL, 1024, DFF, DFF}; pg8::StaticOrder S; S.init(g.M, g.N, G, c, g.K);
            EpiDown E{(const bf16_t*)(ws + OFF_X1), p.b_down, (const float*)(ws + OFF_MOD), p.out, (float*)(ws + OFF_AU)};
            S.wgm = WGM_N1024; S.split_tail(2, 4); pg8::gemm_phase(lds, g, S, E); } } PH_SYNC(12); }
    if (lo <= 13 && 13 < hi) { if constexpr (PH_ON(13)) { for (int rep = (p.rep_mask >> 13) & 1; rep >= 0; --rep) phase_ln2(p, rep > 0); } PH_SYNC(13); }
}

extern "C" void kernel_launch(void* const* d_in, const int* in_sizes, int n_in, void* d_out, int out_size, void* d_ws, size_t ws_size, hipStream_t stream) {
    static int grid = 0;
    if (grid == 0) {
        if (n_in != 27 || ws_size < WS_NEED) { fprintf(stderr, "kernel_launch: n_in %d ws %zu (need %zu)\n", n_in, ws_size, (size_t)WS_NEED); grid = -1; return; }
        int dev = 0, cus = 0, per_cu = 0;
        hipGetDevice(&dev); hipDeviceGetAttribute(&cus, hipDeviceAttributeMultiprocessorCount, dev);
        if (hipFuncSetAttribute((const void*)mega_fwd, hipFuncAttributeMaxDynamicSharedMemorySize, LDS_BYTES) != hipSuccess) { fprintf(stderr, "hipFuncSetAttribute failed\n"); grid = -1; return; }
        if (hipOccupancyMaxActiveBlocksPerMultiprocessor(&per_cu, (const void*)mega_fwd, 512, LDS_BYTES) != hipSuccess || per_cu < 1) { fprintf(stderr, "occupancy query: %d\n", per_cu); per_cu = 1; }
        (void)hipGetLastError();
        grid = cus * 1;
    }
    if (grid < 0) return;
    Params p{};
    const float** f = (const float**)&p;
    for (int i = 0; i < 27; ++i) f[i] = (const float*)d_in[i];
    p.out = (float*)d_out; p.ws = (unsigned char*)d_ws; p.ph_lo = 0; p.ph_hi = NPHASES; p.rep_mask = REP_MASK; p.pad = 0;
    if (hipMemsetAsync((char*)d_ws + OFF_BAR, 0, XCD_BAR_WORDS * 4, stream) != hipSuccess) { fprintf(stderr, "memset failed\n"); return; }
    void* args[] = {&p};
    hipError_t e = hipLaunchCooperativeKernel((const void*)mega_fwd, dim3(grid), dim3(512), args, LDS_BYTES, stream);
    if (e != hipSuccess) fprintf(stderr, "cooperative launch failed: %s (grid %d)\n", hipGetErrorString(e), grid);
}
```
